# Optimizing an MI355X kernel written in HIP

```python
import jax, jax.numpy as jnp
from jax import lax
import numpy as np

D_MODEL = 1024
BATCH = 2
SEQ = 16384
DEPTH = 1

MLA_HEADS = 8
QK_NOPE = 64
QK_ROPE = 32
V_HEAD = 64
Q_LORA = 384
KV_LORA = 256
ROPE_THETA = 10000.0
Q_BLOCK = 128
LRU_WIDTH = D_MODEL
LRU_BLOCKS = 8
LRU_BLOCK = LRU_WIDTH // LRU_BLOCKS
CONV_WIDTH = 4
LRU_C = 8.0
D_FF = 2816
FFN_RES_WEIGHT = 0.5
NORM_EPS = 1e-6
IN_SPLITS = (Q_LORA, KV_LORA, QK_ROPE, LRU_WIDTH, LRU_WIDTH, D_MODEL, D_MODEL)
D_IN = Q_LORA + KV_LORA + QK_ROPE + 2 * LRU_WIDTH + 2 * D_MODEL

kernel_name = 'hybrid_mla_rglru_macaron_sandwich'


def _rmsnorm(x, g):
    xf = x.astype(jnp.float32)
    y = xf * lax.rsqrt(jnp.mean(xf * xf, axis=-1, keepdims=True) + NORM_EPS)
    return (y * g.astype(jnp.float32)).astype(x.dtype)


def _swiglu(x, w_gate, w_up, w_down):
    return (jax.nn.silu(x @ w_gate) * (x @ w_up)) @ w_down


def _half_ffn(h, pre_g, w_gate, w_up, w_down, post_g):
    y = _swiglu(_rmsnorm(h, pre_g), w_gate, w_up, w_down)
    return h + FFN_RES_WEIGHT * _rmsnorm(y, post_g)


def _rope_tables(positions):
    half = QK_ROPE // 2
    inv_freq = ROPE_THETA ** (-jnp.arange(half, dtype=jnp.float32) / half)
    ang = positions.astype(jnp.float32)[..., None] * inv_freq
    return jnp.cos(ang), jnp.sin(ang)


def _apply_rope(x, cos, sin):
    half = x.shape[-1] // 2
    xf = x.astype(jnp.float32)
    x1, x2 = xf[..., :half], xf[..., half:]
    return jnp.concatenate([x1 * cos - x2 * sin, x2 * cos + x1 * sin], axis=-1).astype(x.dtype)


def _mla_branch(c_q, c_kv, k_rope_raw, positions, q_norm_g, w_uq, kv_norm_g, w_ukv, w_o_mla):
    b, s = c_q.shape[0], c_q.shape[1]
    q = (_rmsnorm(c_q, q_norm_g) @ w_uq).reshape(b, s, MLA_HEADS, QK_NOPE + QK_ROPE)
    kv = (_rmsnorm(c_kv, kv_norm_g) @ w_ukv).reshape(b, s, MLA_HEADS, QK_NOPE + V_HEAD)
    q_nope, q_rope = q[..., :QK_NOPE], q[..., QK_NOPE:]
    k_nope, v = kv[..., :QK_NOPE], kv[..., QK_NOPE:]
    cos, sin = _rope_tables(positions)
    q_rope = _apply_rope(q_rope, cos[:, :, None, :], sin[:, :, None, :])
    k_rope = _apply_rope(k_rope_raw, cos, sin)
    scale = (QK_NOPE + QK_ROPE) ** -0.5
    k_idx = jnp.arange(s)

    def attend(i):
        start = i * Q_BLOCK
        qn = lax.dynamic_slice_in_dim(q_nope, start, Q_BLOCK, axis=1)
        qr = lax.dynamic_slice_in_dim(q_rope, start, Q_BLOCK, axis=1)
        sc = jnp.einsum('bqhd,bkhd->bhqk', qn, k_nope) + jnp.einsum('bqhr,bkr->bhqk', qr, k_rope)
        sc = sc.astype(jnp.float32) * scale
        causal = k_idx[None, :] <= (start + jnp.arange(Q_BLOCK))[:, None]
        sc = jnp.where(causal[None, None], sc, -jnp.inf)
        p = jax.nn.softmax(sc, axis=-1).astype(v.dtype)
        return jnp.einsum('bhqk,bkhd->bqhd', p, v)

    o = lax.map(attend, jnp.arange(s // Q_BLOCK))
    o = jnp.moveaxis(o, 0, 1).reshape(b, s, MLA_HEADS * V_HEAD)
    return o @ w_o_mla


def _lru_combine(left, right):
    a_l, b_l = left
    a_r, b_r = right
    return a_l * a_r, a_r * b_l + b_r


def _rglru_branch(xb, yb, conv_w, conv_b, w_rg, b_rg, w_ig, b_ig, lru_lambda, w_o_lru):
    b, s, w = xb.shape
    xpad = jnp.pad(xb, ((0, 0), (CONV_WIDTH - 1, 0), (0, 0)))
    xc = conv_b + sum(xpad[:, k:k + s] * conv_w[k] for k in range(CONV_WIDTH))
    xg = xc.reshape(b, s, LRU_BLOCKS, LRU_BLOCK)
    r = jax.nn.sigmoid(jnp.einsum('bsgi,gij->bsgj', xg, w_rg) + b_rg).reshape(b, s, w)
    ig = jax.nn.sigmoid(jnp.einsum('bsgi,gij->bsgj', xg, w_ig) + b_ig).reshape(b, s, w)
    log_a = -LRU_C * r.astype(jnp.float32) * jax.nn.softplus(-lru_lambda.astype(jnp.float32))
    a = jnp.exp(log_a)
    gated_x = jnp.sqrt(-jnp.expm1(2.0 * log_a)) * (ig * xc).astype(jnp.float32)
    _, h = lax.associative_scan(_lru_combine, (a, gated_x), axis=1)
    return (h.astype(xb.dtype) * jax.nn.gelu(yb)) @ w_o_lru


def setup_inputs(seed: int = 0) -> dict:
    key = jax.random.key(seed)
    ks = jax.random.split(key, 32)
    L = DEPTH

    def dense(k, fan_in, *shape):
        return jax.random.normal(k, (L,) + shape, jnp.float32) * fan_in ** -0.5

    def gain(k, dim):
        return 1.0 + 0.02 * jax.random.normal(k, (L, dim), jnp.float32)

    def bias(k, *shape):
        return 0.01 * jax.random.normal(k, (L,) + shape, jnp.float32)

    x = jax.random.normal(ks[0], (BATCH, SEQ, D_MODEL), jnp.float32)
    positions = jnp.broadcast_to(jnp.arange(SEQ, dtype=jnp.int32), (BATCH, SEQ))
    a_c = jax.random.uniform(ks[20], (L, LRU_WIDTH), jnp.float32, 0.9, 0.999)
    a0 = a_c ** (1.0 / LRU_C)
    lru_lambda = jnp.log(a0) - jnp.log1p(-a0)
    return {
        'x': x,
        'positions': positions,
        'ffn1_pre_g': gain(ks[1], D_MODEL),
        'ffn1_w_gate': dense(ks[2], D_MODEL, D_MODEL, D_FF),
        'ffn1_w_up': dense(ks[3], D_MODEL, D_MODEL, D_FF),
        'ffn1_w_down': dense(ks[4], D_FF, D_FF, D_MODEL),
        'ffn1_post_g': gain(ks[5], D_MODEL),
        'mix_pre_g': gain(ks[6], D_MODEL),
        'w_in': dense(ks[7], D_MODEL, D_MODEL, D_IN),
        'q_norm_g': gain(ks[8], Q_LORA),
        'w_uq': dense(ks[9], Q_LORA, Q_LORA, MLA_HEADS * (QK_NOPE + QK_ROPE)),
        'kv_norm_g': gain(ks[10], KV_LORA),
        'w_ukv': dense(ks[11], KV_LORA, KV_LORA, MLA_HEADS * (QK_NOPE + V_HEAD)),
        'w_o_mla': dense(ks[12], MLA_HEADS * V_HEAD, MLA_HEADS * V_HEAD, D_MODEL),
        'conv_w': dense(ks[13], CONV_WIDTH, CONV_WIDTH, LRU_WIDTH),
        'conv_b': bias(ks[14], LRU_WIDTH),
        'w_rg': dense(ks[15], LRU_BLOCK, LRU_BLOCKS, LRU_BLOCK, LRU_BLOCK),
        'b_rg': bias(ks[16], LRU_BLOCKS, LRU_BLOCK),
        'w_ig': dense(ks[17], LRU_BLOCK, LRU_BLOCKS, LRU_BLOCK, LRU_BLOCK),
        'b_ig': bias(ks[18], LRU_BLOCKS, LRU_BLOCK),
        'lru_lambda': lru_lambda,
        'w_o_lru': dense(ks[19], LRU_WIDTH, LRU_WIDTH, D_MODEL),
        'w_out': dense(ks[21], D_MODEL, D_MODEL, D_MODEL),
        'mix_post_g': gain(ks[22], D_MODEL),
        'ffn2_pre_g': gain(ks[23], D_MODEL),
        'ffn2_w_gate': dense(ks[24], D_MODEL, D_MODEL, D_FF),
        'ffn2_w_up': dense(ks[25], D_MODEL, D_MODEL, D_FF),
        'ffn2_w_down': dense(ks[26], D_FF, D_FF, D_MODEL),
        'ffn2_post_g': gain(ks[27], D_MODEL),
    }


def reference(x, positions, ffn1_pre_g, ffn1_w_gate, ffn1_w_up, ffn1_w_down, ffn1_post_g,
              mix_pre_g, w_in, q_norm_g, w_uq, kv_norm_g, w_ukv, w_o_mla,
              conv_w, conv_b, w_rg, b_rg, w_ig, b_ig, lru_lambda, w_o_lru, w_out, mix_post_g,
              ffn2_pre_g, ffn2_w_gate, ffn2_w_up, ffn2_w_down, ffn2_post_g):
    split_points = np.cumsum(IN_SPLITS)[:-1].tolist()
    h = x
    for l in range(DEPTH):
        h = _half_ffn(h, ffn1_pre_g[l], ffn1_w_gate[l], ffn1_w_up[l], ffn1_w_down[l], ffn1_post_g[l])
        u = _rmsnorm(h, mix_pre_g[l])
        c_q, c_kv, k_rope_raw, xb, yb, gate_mla, gate_lru = jnp.split(u @ w_in[l], split_points, axis=-1)
        o_mla = _mla_branch(c_q, c_kv, k_rope_raw, positions, q_norm_g[l], w_uq[l],
                            kv_norm_g[l], w_ukv[l], w_o_mla[l])
        o_lru = _rglru_branch(xb, yb, conv_w[l], conv_b[l], w_rg[l], b_rg[l], w_ig[l], b_ig[l],
                              lru_lambda[l], w_o_lru[l])
        merged = jax.nn.sigmoid(gate_mla) * o_mla + jax.nn.sigmoid(gate_lru) * o_lru
        h = h + _rmsnorm(merged @ w_out[l], mix_post_g[l])
        h = _half_ffn(h, ffn2_pre_g[l], ffn2_w_gate[l], ffn2_w_up[l], ffn2_w_down[l], ffn2_post_g[l])
    return h
```

```cpp
#include <hip/hip_runtime.h>
#include <hip/hip_cooperative_groups.h>
#include <hip/hip_bf16.h>
#include <cstdio>
#include <cstdint>
namespace cg = cooperative_groups;

#define LAS __attribute__((address_space(3)))
#define GAS __attribute__((address_space(1)))
typedef unsigned short bf16_t;
typedef short bf16x8 __attribute__((ext_vector_type(8)));
typedef short s16x4 __attribute__((ext_vector_type(4)));
typedef float f32x4 __attribute__((ext_vector_type(4)));
typedef float f32x2 __attribute__((ext_vector_type(2)));
typedef float f32x16 __attribute__((ext_vector_type(16)));
typedef unsigned u32x4 __attribute__((ext_vector_type(4)));
typedef unsigned u32x2 __attribute__((ext_vector_type(2)));

constexpr int SEQ = 16384, NB = 2, M = NB * SEQ, D = 1024, DFF = 2816;
constexpr int NHEAD = 8, DQK = 96, DVH = 64, QLORA = 384, KVLORA = 256, ROPE = 32;
constexpr int NWIN = 4864;
constexpr int LATP = 768;
constexpr float EPS = 1e-6f;
constexpr float QSCALE = 0.10206207261596575f * 1.4426950408889634f;
constexpr int NCHUNK = 128, CHUNK = SEQ / NCHUNK;

constexpr size_t MiB = 1u << 20, KiB = 1u << 10;
constexpr size_t WS_SSY1 = 0, WS_SSQ = 128 * KiB, WS_SSKV = 256 * KiB, WS_SSZ = 384 * KiB, WS_SSY2 = 512 * KiB, WS_RS0 = 640 * KiB, WS_RS1 = 768 * KiB, WS_RS2 = 896 * KiB, WS_NLA = 1 * MiB;
constexpr size_t WS_BAR = 1 * MiB + 64 * KiB;
constexpr size_t WS_XCNT = 1 * MiB + 128 * KiB;
constexpr size_t WS_XSLOT = 492 * MiB;
constexpr size_t WS_CS = 2 * MiB;
constexpr size_t WS_PS = 6 * MiB;
constexpr size_t WS_WGU1 = 8 * MiB, WS_WD1 = 19 * MiB, WS_WGU2 = 25 * MiB, WS_WD2 = 36 * MiB, WS_WIN = 42 * MiB, WS_WUQ = 52 * MiB, WS_WUKV = 53 * MiB,
                 WS_WM = 54 * MiB, WS_WL = 55 * MiB, WS_WO = 57 * MiB, WS_WGATE = 59 * MiB;
constexpr size_t WS_Y = 60 * MiB;
constexpr size_t WS_XN = 124 * MiB;
constexpr size_t WS_ACT = 188 * MiB;
constexpr size_t WS_LAT = 188 * MiB;
constexpr size_t WS_XB = 236 * MiB;
constexpr size_t WS_GY = 300 * MiB, WS_SA = 364 * MiB, WS_SB = 428 * MiB;
constexpr size_t WS_LA = 236 * MiB;
constexpr size_t WS_Q = 236 * MiB, WS_K = 284 * MiB, WS_V = 332 * MiB;
constexpr size_t WS_O = 188 * MiB;
constexpr size_t WS_MG = 236 * MiB;
constexpr size_t WS_Z = 300 * MiB;
constexpr size_t WS_END = 494 * MiB;

__device__ __forceinline__ unsigned cvt_pk_bf16(float lo, float hi) { unsigned r; asm volatile("v_cvt_pk_bf16_f32 %0, %1, %2" : "=v"(r) : "v"(lo), "v"(hi)); return r; }
__device__ __forceinline__ float bf_lo(unsigned w) { return __uint_as_float(w << 16); }
__device__ __forceinline__ float bf_hi(unsigned w) { return __uint_as_float(w & 0xffff0000u); }
__device__ __forceinline__ float fsigmoid(float x) { return __builtin_amdgcn_rcpf(1.f + __builtin_amdgcn_exp2f(-1.4426950408889634f * x)); }
__device__ __forceinline__ float fsilu(float x) { return x * fsigmoid(x); }
__device__ __forceinline__ float fgelu(float x) { return x * fsigmoid(1.5957691216057308f * (x + 0.044715f * x * x * x)); }
__device__ __forceinline__ float wave_sum(float v) {
#pragma unroll
    for (int o = 1; o < 64; o <<= 1) v += __shfl_xor(v, o);
    return v;
}
__device__ __forceinline__ void atomic_addf(float* p, float v) { (void)__hip_atomic_fetch_add(p, v, __ATOMIC_RELAXED, __HIP_MEMORY_SCOPE_AGENT); }

namespace pg8 {
#define PG8_LAS __attribute__((address_space(3)))
constexpr int BM = 256, BK = 64, HALF = 128, HTB = HALF * BK * 2, STAGE_BYTES = 8 * HTB, NXCD = 8, WGM = 8;
__host__ __device__ __forceinline__ int lds_byte(int r, int c) { const int st = (r >> 4) * 2 + (c >> 5), rr = r & 15, cc = c & 31, ob = rr * 64 + cc * 2; return st * 1024 + (ob ^ (((ob >> 9) & 1) << 5)); }
__host__ __device__ __forceinline__ void stage_rc(int b, int& R, int& C) { const int st = b / 1024, sb = b % 1024, swz = sb ^ (((sb >> 9) & 1) << 5); R = (st >> 1) * 16 + swz / 64; C = (st & 1) * 32 + (swz % 64) / 2; }
__host__ __device__ __forceinline__ int perm32(int rho) { const int n = rho >> 4, i = rho & 15; return 8 * (i >> 2) + 4 * n + (i & 3); }

struct Unit { int pm, pn; };
struct Gemm { const bf16_t* A; const bf16_t* Bt; int M, N, K, lda, acol; };

struct StaticOrder {
    int nM, nN, nwg, G, c;
    __host__ __device__ void init(int M_, int N_, int G_, int c_) { nM = M_ / BM; nN = N_ / BM; nwg = nM * nN; G = G_; c = c_; }
    __host__ __device__ bool next(int i, Unit& u) const {
        const long L = (long)i * G + c; if (L >= nwg) return false;
        int wgid = (int)L; { const int q = nwg / NXCD, r = nwg % NXCD, xcd = wgid % NXCD, off = wgid / NXCD; wgid = (xcd < r ? xcd * (q + 1) : r * (q + 1) + (xcd - r) * q) + off; }
        const int nig = WGM * nN, gid = wgid / nig, fm = gid * WGM, gsz = (nM - fm) < WGM ? (nM - fm) : WGM;
        u.pm = fm + ((wgid % nig) % gsz); u.pn = (wgid % nig) / gsz; return true;
    }
};

template <class Epi>
__device__ __forceinline__ void gemm_phase(PG8_LAS unsigned char* lds, const Gemm g, const StaticOrder& S, const Epi& E) {
    const int tid = threadIdx.x, wid = __builtin_amdgcn_readfirstlane(tid >> 6), lane = tid & 63, wr = wid >> 2, wc = wid & 3, fr = lane & 15, fq = lane >> 4;
    int Kop = g.K; asm volatile("" : "+s"(Kop));
    const int K = Kop, nt = K / BK;
    unsigned voffA[2], voffB[2];
#pragma unroll
    for (int i = 0; i < 2; ++i) { int R, C; stage_rc(tid * 16 + i * 8192, R, C); const int Rb = Epi::PERM ? ((R & ~31) + perm32(R & 31)) : R;
        voffA[i] = (unsigned)(R * g.lda + C) * 2u; voffB[i] = (unsigned)(Rb * K + C) * 2u; }
    const size_t kstep = (size_t)(BK * 2);
    const size_t hstepA = (size_t)HALF * g.lda * 2, hstepB = (size_t)HALF * K * 2;
    const size_t tstepA = 2 * hstepA, tstepB = 2 * hstepB;
    const unsigned ldsw = (unsigned)wid * 1024u;
    const int aoff = lds_byte(wr * 64 + fr, fq * 8), boff = lds_byte(wc * 32 + fr, fq * 8);
#define PG8_SA(b, h) (((b) * 2 + (h)) * HTB)
#define PG8_SB(b, h) ((4 + (b) * 2 + (h)) * HTB)
#define PG8_STAGE(bufoff, gbase, voff) do { _Pragma("unroll") for (int _i = 0; _i < 2; ++_i) \
        __builtin_amdgcn_global_load_lds((const unsigned*)((const char*)(gbase) + (voff)[_i]), (PG8_LAS unsigned*)(lds + (bufoff) + ldsw + _i * 8192), 16, 0, 0); } while (0)
#define PG8_LDA(dst, b, h) do { _Pragma("unroll") for (int m = 0; m < 4; ++m) _Pragma("unroll") for (int k = 0; k < 2; ++k) dst[m][k] = *(const PG8_LAS bf16x8*)(lds + PG8_SA(b, h) + aoff + m * 2048 + k * 1024); } while (0)
#define PG8_LDB(dst, b, h) do { _Pragma("unroll") for (int n = 0; n < 2; ++n) _Pragma("unroll") for (int k = 0; k < 2; ++k) dst[n][k] = *(const PG8_LAS bf16x8*)(lds + PG8_SB(b, h) + boff + n * 2048 + k * 1024); } while (0)
#define PG8_MMA(ai, bj, At, Bt) do { __builtin_amdgcn_s_setprio(1); _Pragma("unroll") for (int m = 0; m < 4; ++m) _Pragma("unroll") for (int n = 0; n < 2; ++n) _Pragma("unroll") for (int k = 0; k < 2; ++k) \
        acc[ai][bj][m][n] = __builtin_amdgcn_mfma_f32_16x16x32_bf16(Bt[n][k], At[m][k], acc[ai][bj][m][n], 0, 0, 0); __builtin_amdgcn_s_setprio(0); } while (0)
#define PG8_WAIT_V(n) asm volatile("s_waitcnt vmcnt(" #n ")" ::: "memory")
#define PG8_WAIT_L(n) asm volatile("s_waitcnt lgkmcnt(" #n ")" ::: "memory")
#define PG8_BAR __builtin_amdgcn_s_barrier()
#define PG8_SCHED __builtin_amdgcn_sched_barrier(0)
    Unit cur, nxt; int ui = 0;
    if (!S.next(0, cur)) return;
    f32x4 acc[2][2][4][2];
#pragma unroll
    for (int a = 0; a < 2; ++a)
#pragma unroll
        for (int b = 0; b < 2; ++b)
#pragma unroll
            for (int m = 0; m < 4; ++m)
#pragma unroll
                for (int n = 0; n < 2; ++n) acc[a][b][m][n] = (f32x4){0.f, 0.f, 0.f, 0.f};
    bf16x8 At[4][2], B0[2][2], B1[2][2];
    const char* cA = (const char*)g.A + (size_t)cur.pm * tstepA + (size_t)cur.pn * g.acol * 2; const char* cB = (const char*)g.Bt + (size_t)cur.pn * tstepB;
    PG8_STAGE(PG8_SB(0, 0), cB, voffB); PG8_STAGE(PG8_SB(0, 1), cB + hstepB, voffB); PG8_STAGE(PG8_SA(0, 0), cA, voffA); PG8_STAGE(PG8_SA(0, 1), cA + hstepA, voffA);
    if (wr == 1) PG8_BAR;
    PG8_WAIT_V(2); PG8_BAR;
    PG8_STAGE(PG8_SB(1, 0), cB + kstep, voffB); PG8_STAGE(PG8_SA(1, 0), cA + kstep, voffA); PG8_STAGE(PG8_SB(1, 1), cB + hstepB + kstep, voffB);
    PG8_WAIT_V(6); PG8_BAR;
    for (;;) {
        const bool has_next = S.next(ui + 1, nxt);
        const char* nA = has_next ? (const char*)g.A + (size_t)nxt.pm * tstepA + (size_t)nxt.pn * g.acol * 2 : cA; const char* nB = has_next ? (const char*)g.Bt + (size_t)nxt.pn * tstepB : cB;
#pragma clang loop unroll(disable)
        for (int t = 0; t < nt; t += 2) {
            const bool last = (t == nt - 2);
            const char* a1 = cA + (size_t)(t + 1) * kstep;
            const char* a2 = last ? nA : cA + (size_t)(t + 2) * kstep; const char* b2 = last ? nB : cB + (size_t)(t + 2) * kstep;
            const char* a3 = a2 + kstep; const char* b3 = b2 + kstep;
            PG8_LDB(B0, 0, 0); PG8_LDB(B1, 0, 1); PG8_SCHED; PG8_LDA(At, 0, 0); PG8_STAGE(PG8_SA(1, 1), a1 + hstepA, voffA);
            PG8_WAIT_V(8); PG8_WAIT_L(0); PG8_BAR; PG8_MMA(0, 0, At, B0); PG8_MMA(0, 1, At, B1); PG8_BAR; PG8_SCHED;
            PG8_LDA(At, 0, 1); PG8_STAGE(PG8_SB(0, 0), b2, voffB); PG8_STAGE(PG8_SB(0, 1), b2 + hstepB, voffB); PG8_STAGE(PG8_SA(0, 0), a2, voffA);
            PG8_WAIT_V(8); PG8_WAIT_L(0); PG8_BAR; PG8_MMA(1, 0, At, B0); PG8_MMA(1, 1, At, B1); PG8_BAR; PG8_SCHED;
            PG8_LDB(B0, 1, 0); PG8_LDB(B1, 1, 1); PG8_SCHED; PG8_LDA(At, 1, 0); PG8_STAGE(PG8_SA(0, 1), a2 + hstepA, voffA);
            PG8_WAIT_V(8); PG8_WAIT_L(0); PG8_BAR; PG8_MMA(0, 0, At, B0); PG8_MMA(0, 1, At, B1); PG8_BAR; PG8_SCHED;
            PG8_LDA(At, 1, 1); PG8_STAGE(PG8_SB(1, 0), b3, voffB); PG8_STAGE(PG8_SB(1, 1), b3 + hstepB, voffB); PG8_STAGE(PG8_SA(1, 0), a3, voffA);
            PG8_WAIT_V(8); PG8_WAIT_L(0); PG8_BAR; PG8_MMA(1, 0, At, B0); PG8_MMA(1, 1, At, B1); PG8_BAR; PG8_SCHED;
        }
        if (wr == 0) PG8_BAR;
        { int frx = fr, fqx = fq; asm volatile("" : "+v"(frx), "+v"(fqx));
          E(acc, cur, wr, wc, frx, fqx); }
        if (!has_next) break;
#pragma unroll
        for (int a = 0; a < 2; ++a)
#pragma unroll
            for (int b = 0; b < 2; ++b)
#pragma unroll
                for (int m = 0; m < 4; ++m)
#pragma unroll
                    for (int n = 0; n < 2; ++n) acc[a][b][m][n] = (f32x4){0.f, 0.f, 0.f, 0.f};
        cur = nxt; cA = nA; cB = nB; ++ui;
        if (wr == 1) PG8_BAR;
    }
    PG8_WAIT_V(0);
    PG8_BAR;
#undef PG8_SA
#undef PG8_SB
#undef PG8_STAGE
#undef PG8_LDA
#undef PG8_LDB
#undef PG8_MMA
#undef PG8_WAIT_V
#undef PG8_WAIT_L
#undef PG8_BAR
#undef PG8_SCHED
}

typedef const f32x4 (&AccRef)[2][2][4][2];
#define EPI_FENCE() asm volatile("" ::: "memory")

struct EpiSwiGLU {
    static constexpr bool PERM = true;
    bf16_t* O; int ldc; const float* rs; bool from_ss;
    __device__ __forceinline__ void operator()(AccRef acc, const Unit& u, int wr, int wc, int fr, int fq) const {
        bf16_t* base = O + (size_t)u.pm * BM * ldc + u.pn * 128 + wc * 32; const float* rsb = rs + u.pm * BM; const int r0 = wr * 64 + fr;
        float sv[2][4];
#pragma unroll
        for (int ai = 0; ai < 2; ++ai)
#pragma unroll
            for (int m = 0; m < 4; ++m) { const float t = rsb[r0 + ai * HALF + m * 16]; sv[ai][m] = from_ss ? rsqrtf(t * (1.f / D) + EPS) : t; }
#pragma unroll
        for (int ai = 0; ai < 2; ++ai)
#pragma unroll
            for (int m = 0; m < 4; ++m) { const int rl = r0 + ai * HALF + m * 16; const float s = sv[ai][m]; const unsigned off = (unsigned)(rl * ldc + 8 * fq);
                const f32x4 g0 = acc[ai][0][m][0] * s, g1 = acc[ai][0][m][1] * s, u0 = acc[ai][1][m][0] * s, u1 = acc[ai][1][m][1] * s;
                u32x4 w; w.x = cvt_pk_bf16(fsilu(g0[0]) * u0[0], fsilu(g0[1]) * u0[1]); w.y = cvt_pk_bf16(fsilu(g0[2]) * u0[2], fsilu(g0[3]) * u0[3]);
                w.z = cvt_pk_bf16(fsilu(g1[0]) * u1[0], fsilu(g1[1]) * u1[1]); w.w = cvt_pk_bf16(fsilu(g1[2]) * u1[2], fsilu(g1[3]) * u1[3]);
                *(u32x4*)(base + off) = w;
                EPI_FENCE(); }
    }
};
struct EpiBfSS {
    static constexpr bool PERM = true;
    bf16_t* O; int ldc; float* ss;
    __device__ __forceinline__ void operator()(AccRef acc, const Unit& u, int wr, int wc, int fr, int fq) const {
        bf16_t* base = O + (size_t)u.pm * BM * ldc + u.pn * BM + wc * 32; float* ssb = ss + u.pm * BM; const int r0 = wr * 64 + fr;
#pragma unroll
        for (int ai = 0; ai < 2; ++ai)
#pragma unroll
            for (int m = 0; m < 4; ++m) { const int rl = r0 + ai * HALF + m * 16; const unsigned off = (unsigned)(rl * ldc + 8 * fq); float q = 0.f;
#pragma unroll
                for (int bj = 0; bj < 2; ++bj) { const f32x4 v0 = acc[ai][bj][m][0], v1 = acc[ai][bj][m][1];
                    q += (v0[0] * v0[0] + v0[1] * v0[1]) + (v0[2] * v0[2] + v0[3] * v0[3]) + (v1[0] * v1[0] + v1[1] * v1[1]) + (v1[2] * v1[2] + v1[3] * v1[3]);
                    u32x4 w; w.x = cvt_pk_bf16(v0[0], v0[1]); w.y = cvt_pk_bf16(v0[2], v0[3]); w.z = cvt_pk_bf16(v1[0], v1[1]); w.w = cvt_pk_bf16(v1[2], v1[3]);
                    *(u32x4*)(base + off + bj * HALF) = w; }
                q += __shfl_xor(q, 16); q += __shfl_xor(q, 32);
                if (fq == 0) atomic_addf(ssb + rl, q);
                EPI_FENCE(); }
    }
};
struct EpiWin {
    static constexpr bool PERM = true;
    bf16_t* LAT; bf16_t* XB4; const float* rs; float* ssq; float* sskv;
    __device__ __forceinline__ void operator()(AccRef acc, const Unit& u, int wr, int wc, int fr, int fq) const {
        const int pn = u.pn; const bool lat = pn < 3; const int seg = lat ? 0 : ((pn - 3) >> 2); const int ldc = lat ? LATP : D;
        bf16_t* base = lat ? (LAT + (size_t)u.pm * BM * LATP + pn * BM + wc * 32) : (XB4 + (size_t)seg * M * D + (size_t)u.pm * BM * D + ((pn - 3) & 3) * BM + wc * 32);
        const float* rsb = rs + u.pm * BM; float* ssqb = ssq + u.pm * BM; float* sskvb = sskv + u.pm * BM; const int r0 = wr * 64 + fr;
        float sv[2][4];
#pragma unroll
        for (int ai = 0; ai < 2; ++ai)
#pragma unroll
            for (int m = 0; m < 4; ++m) sv[ai][m] = rsb[r0 + ai * HALF + m * 16];
#pragma unroll
        for (int ai = 0; ai < 2; ++ai)
#pragma unroll
            for (int m = 0; m < 4; ++m) { const int rl = r0 + ai * HALF + m * 16; const float s = sv[ai][m]; const unsigned off = (unsigned)(rl * ldc + 8 * fq);
#pragma unroll
                for (int bj = 0; bj < 2; ++bj) { f32x4 v0 = acc[ai][bj][m][0] * s, v1 = acc[ai][bj][m][1] * s;
                    if (lat) { const int sid = pn * 2 + bj;
                        if (sid < 5) { float q = (v0[0] * v0[0] + v0[1] * v0[1]) + (v0[2] * v0[2] + v0[3] * v0[3]) + (v1[0] * v1[0] + v1[1] * v1[1]) + (v1[2] * v1[2] + v1[3] * v1[3]);
                            q += __shfl_xor(q, 16); q += __shfl_xor(q, 32);
                            if (fq == 0) atomic_addf((sid < 3 ? ssqb : sskvb) + rl, q); } }
                    else if (seg == 1) {
#pragma unroll
                        for (int i = 0; i < 4; ++i) { v0[i] = fgelu(v0[i]); v1[i] = fgelu(v1[i]); } }
                    else if (seg >= 2) {
#pragma unroll
                        for (int i = 0; i < 4; ++i) { v0[i] = fsigmoid(v0[i]); v1[i] = fsigmoid(v1[i]); } }
                    u32x4 w; w.x = cvt_pk_bf16(v0[0], v0[1]); w.y = cvt_pk_bf16(v0[2], v0[3]); w.z = cvt_pk_bf16(v1[0], v1[1]); w.w = cvt_pk_bf16(v1[2], v1[3]);
                    *(u32x4*)(base + off + bj * HALF) = w; }
                EPI_FENCE(); }
    }
};
__device__ __forceinline__ float one_minus_exp(float y) {
    const float p = -y * (1.f + y * 0.5f * (1.f + y * (1.f / 3.f) * (1.f + y * 0.25f * (1.f + y * 0.2f * (1.f + y * (1.f / 6.f))))));
    const float e = 1.f - __builtin_amdgcn_exp2f(y * 1.4426950408889634f);
    return y > -0.25f ? p : e;
}
struct EpiLru {
    static constexpr bool PERM = true;
    bf16_t* XG; bf16_t* LA; const float* b_rg; const float* b_ig; const float* nla;
    __device__ __forceinline__ void operator()(AccRef acc, const Unit& u, int wr, int wc, int fr, int fq) const {
        const int chu = u.pn * 128 + wc * 32; const size_t ub = (size_t)u.pm * BM * D + chu; bf16_t* xgb = XG + ub; bf16_t* lab = LA + ub; const int r0 = wr * 64 + fr;
        f32x4 br[2], bi[2], nl[2];
#pragma unroll
        for (int n = 0; n < 2; ++n) { br[n] = *(const f32x4*)(b_rg + chu + 8 * fq + 4 * n); bi[n] = *(const f32x4*)(b_ig + chu + 8 * fq + 4 * n); nl[n] = *(const f32x4*)(nla + chu + 8 * fq + 4 * n); }
        u32x4 xwv[2][4];
#pragma unroll
        for (int ai = 0; ai < 2; ++ai)
#pragma unroll
            for (int m = 0; m < 4; ++m) xwv[ai][m] = *(const u32x4*)(xgb + (unsigned)((r0 + ai * HALF + m * 16) * D + 8 * fq));
#pragma unroll
        for (int ai = 0; ai < 2; ++ai)
#pragma unroll
            for (int m = 0; m < 4; ++m) { const int rl = r0 + ai * HALF + m * 16; const unsigned off = (unsigned)(rl * D + 8 * fq);
                const u32x4 xw = xwv[ai][m]; const float xc[8] = {bf_lo(xw.x), bf_hi(xw.x), bf_lo(xw.y), bf_hi(xw.y), bf_lo(xw.z), bf_hi(xw.z), bf_lo(xw.w), bf_hi(xw.w)};
                float la[8], gx[8];
#pragma unroll
                for (int n = 0; n < 2; ++n) { const f32x4 rv = acc[ai][0][m][n] + br[n], iv = acc[ai][1][m][n] + bi[n];
#pragma unroll
                    for (int i = 0; i < 4; ++i) { const float r = fsigmoid(rv[i]), ig = fsigmoid(iv[i]); la[4 * n + i] = nl[n][i] * r;
                        const float mult = __builtin_sqrtf(fmaxf(one_minus_exp(2.f * la[4 * n + i]), 0.f)); gx[4 * n + i] = mult * (ig * xc[4 * n + i]); } }
                u32x4 wl, wg; wl.x = cvt_pk_bf16(la[0], la[1]); wl.y = cvt_pk_bf16(la[2], la[3]); wl.z = cvt_pk_bf16(la[4], la[5]); wl.w = cvt_pk_bf16(la[6], la[7]);
                wg.x = cvt_pk_bf16(gx[0], gx[1]); wg.y = cvt_pk_bf16(gx[2], gx[3]); wg.z = cvt_pk_bf16(gx[4], gx[5]); wg.w = cvt_pk_bf16(gx[6], gx[7]);
                *(u32x4*)(lab + off) = wl; *(u32x4*)(xgb + off) = wg;
                EPI_FENCE(); }
    }
};
struct EpiQ {
    static constexpr bool PERM = false;
    bf16_t* Q; const float* ssq; const float* cs;
    __device__ __forceinline__ void operator()(AccRef acc, const Unit& u, int wr, int wc, int fr, int fq) const {
        const int b = (u.pm * BM) / SEQ, sp0 = u.pm * BM - b * SEQ; const float* ssb = ssq + u.pm * BM; const float* csb = cs + (size_t)u.pm * BM * 32; const int r0 = wr * 64 + fr;
        bf16_t* hb[2]; bool rope[2];
#pragma unroll
        for (int bj = 0; bj < 2; ++bj) { const int g32 = u.pn * 8 + bj * 4 + wc, head = g32 / 3, part = g32 - head * 3; rope[bj] = part == 2;
            hb[bj] = Q + ((size_t)(b * NHEAD + head) * SEQ + sp0) * DQK + part * 32; }
        const bool anyrope = rope[0] || rope[1];
        float ssv[2][4];
#pragma unroll
        for (int ai = 0; ai < 2; ++ai)
#pragma unroll
            for (int m = 0; m < 4; ++m) ssv[ai][m] = ssb[r0 + ai * HALF + m * 16];
        f32x4 cvn = {}, svn = {};
        if (anyrope) { cvn = *(const f32x4*)(csb + r0 * 32 + 4 * fq); svn = *(const f32x4*)(csb + r0 * 32 + 16 + 4 * fq); }
#pragma unroll
        for (int ai = 0; ai < 2; ++ai)
#pragma unroll
            for (int m = 0; m < 4; ++m) { const int rl = r0 + ai * HALF + m * 16; const float s = rsqrtf(ssv[ai][m] * (1.f / QLORA) + EPS) * QSCALE;
                const unsigned off = (unsigned)(rl * DQK + 4 * fq);
                const f32x4 cv = cvn, sv = svn;
                if (anyrope && !(ai == 1 && m == 3)) { const int rn = r0 + (m == 3 ? HALF : ai * HALF + (m + 1) * 16);
                    cvn = *(const f32x4*)(csb + rn * 32 + 4 * fq); svn = *(const f32x4*)(csb + rn * 32 + 16 + 4 * fq); }
#pragma unroll
                for (int bj = 0; bj < 2; ++bj) { f32x4 v0 = acc[ai][bj][m][0] * s, v1 = acc[ai][bj][m][1] * s;
                    if (rope[bj]) { const f32x4 x1 = v0, x2 = v1; v0 = x1 * cv - x2 * sv; v1 = x2 * cv + x1 * sv; }
                    u32x2 w0, w1; w0.x = cvt_pk_bf16(v0[0], v0[1]); w0.y = cvt_pk_bf16(v0[2], v0[3]); w1.x = cvt_pk_bf16(v1[0], v1[1]); w1.y = cvt_pk_bf16(v1[2], v1[3]);
                    *(u32x2*)(hb[bj] + off) = w0; *(u32x2*)(hb[bj] + off + 16) = w1; }
                EPI_FENCE(); }
    }
};
struct EpiKV {
    static constexpr bool PERM = false;
    bf16_t* Kb; bf16_t* Vb; const float* sskv;
    __device__ __forceinline__ void operator()(AccRef acc, const Unit& u, int wr, int wc, int fr, int fq) const {
        const int b = (u.pm * BM) / SEQ, sp0 = u.pm * BM - b * SEQ; const float* ssb = sskv + u.pm * BM; const int r0 = wr * 64 + fr;
        const bool isk = wc < 2; const int pitch = isk ? DQK : DVH;
        bf16_t* hb[2];
#pragma unroll
        for (int bj = 0; bj < 2; ++bj) { const size_t tok = (size_t)(b * NHEAD + u.pn * 2 + bj) * SEQ + sp0; hb[bj] = isk ? (Kb + tok * DQK + wc * 32) : (Vb + tok * DVH + (wc - 2) * 32); }
        float ssv[2][4];
#pragma unroll
        for (int ai = 0; ai < 2; ++ai)
#pragma unroll
            for (int m = 0; m < 4; ++m) ssv[ai][m] = ssb[r0 + ai * HALF + m * 16];
#pragma unroll
        for (int ai = 0; ai < 2; ++ai)
#pragma unroll
            for (int m = 0; m < 4; ++m) { const int rl = r0 + ai * HALF + m * 16; const float s = rsqrtf(ssv[ai][m] * (1.f / KVLORA) + EPS); const unsigned off = (unsigned)(rl * pitch + 4 * fq);
#pragma unroll
                for (int bj = 0; bj < 2; ++bj) { const f32x4 v0 = acc[ai][bj][m][0] * s, v1 = acc[ai][bj][m][1] * s;
                    u32x2 w0, w1; w0.x = cvt_pk_bf16(v0[0], v0[1]); w0.y = cvt_pk_bf16(v0[2], v0[3]); w1.x = cvt_pk_bf16(v1[0], v1[1]); w1.y = cvt_pk_bf16(v1[2], v1[3]);
                    *(u32x2*)(hb[bj] + off) = w0; *(u32x2*)(hb[bj] + off + 16) = w1; }
                EPI_FENCE(); }
    }
};
template <bool SECOND> struct EpiMerge {
    static constexpr bool PERM = true;
    bf16_t* O; const bf16_t* Gt;
    __device__ __forceinline__ void operator()(AccRef acc, const Unit& u, int wr, int wc, int fr, int fq) const {
        const size_t ub = (size_t)u.pm * BM * D + u.pn * BM + wc * 32; bf16_t* ob = O + ub; const bf16_t* gb = Gt + ub; const int r0 = wr * 64 + fr;
        u32x4 gn[2], pn[2] = {};
        { const unsigned off = (unsigned)(r0 * D + 8 * fq);
#pragma unroll
          for (int bj = 0; bj < 2; ++bj) { gn[bj] = *(const u32x4*)(gb + off + bj * HALF); if (SECOND) pn[bj] = *(const u32x4*)(ob + off + bj * HALF); } }
#pragma unroll
        for (int ai = 0; ai < 2; ++ai)
#pragma unroll
            for (int m = 0; m < 4; ++m) { const int rl = r0 + ai * HALF + m * 16; const unsigned off = (unsigned)(rl * D + 8 * fq);
                u32x4 gw[2], pw[2];
#pragma unroll
                for (int bj = 0; bj < 2; ++bj) { gw[bj] = gn[bj]; pw[bj] = pn[bj]; }
                if (!(ai == 1 && m == 3)) { const int rn = r0 + (m == 3 ? HALF : ai * HALF + (m + 1) * 16); const unsigned offn = (unsigned)(rn * D + 8 * fq);
#pragma unroll
                    for (int bj = 0; bj < 2; ++bj) { gn[bj] = *(const u32x4*)(gb + offn + bj * HALF); if (SECOND) pn[bj] = *(const u32x4*)(ob + offn + bj * HALF); } }
#pragma unroll
                for (int bj = 0; bj < 2; ++bj) { const f32x4 a0 = acc[ai][bj][m][0], a1 = acc[ai][bj][m][1]; const u32x4 g = gw[bj];
                    float o[8] = {bf_lo(g.x) * a0[0], bf_hi(g.x) * a0[1], bf_lo(g.y) * a0[2], bf_hi(g.y) * a0[3], bf_lo(g.z) * a1[0], bf_hi(g.z) * a1[1], bf_lo(g.w) * a1[2], bf_hi(g.w) * a1[3]};
                    if (SECOND) { const u32x4 p = pw[bj];
                        o[0] += bf_lo(p.x); o[1] += bf_hi(p.x); o[2] += bf_lo(p.y); o[3] += bf_hi(p.y); o[4] += bf_lo(p.z); o[5] += bf_hi(p.z); o[6] += bf_lo(p.w); o[7] += bf_hi(p.w); }
                    u32x4 w; w.x = cvt_pk_bf16(o[0], o[1]); w.y = cvt_pk_bf16(o[2], o[3]); w.z = cvt_pk_bf16(o[4], o[5]); w.w = cvt_pk_bf16(o[6], o[7]);
                    *(u32x4*)(ob + off + bj * HALF) = w; }
                EPI_FENCE(); }
    }
};
template <bool FINAL> struct EpiNormRes {
    static constexpr bool PERM = true;
    float* out; bf16_t* dst; float* ssout; const bf16_t* H; const float* g; float w; float* slots; unsigned* cnt; LAS float* xl;
    __device__ __forceinline__ void operator()(AccRef acc, const Unit& u, int wr, int wc, int fr, int fq) const {
        const int tid = threadIdx.x, lane = tid & 63; const int r0 = wr * 64 + fr;
        LAS float* P = xl; LAS float* S = xl + 1024;
#pragma unroll
        for (int ai = 0; ai < 2; ++ai)
#pragma unroll
            for (int m = 0; m < 4; ++m) { float q = 0.f;
#pragma unroll
                for (int bj = 0; bj < 2; ++bj) { const f32x4 v0 = acc[ai][bj][m][0], v1 = acc[ai][bj][m][1];
                    q += (v0[0] * v0[0] + v0[1] * v0[1]) + (v0[2] * v0[2] + v0[3] * v0[3]) + (v1[0] * v1[0] + v1[1] * v1[1]) + (v1[2] * v1[2] + v1[3] * v1[3]); }
                q += __shfl_xor(q, 16); q += __shfl_xor(q, 32);
                if (fq == 0) P[(r0 + ai * HALF + m * 16) * 4 + wc] = q; }
        __syncthreads();
        unsigned* pc = cnt + 64 * u.pm;
        if (tid < 256) { const float t = (P[tid * 4 + 0] + P[tid * 4 + 1]) + (P[tid * 4 + 2] + P[tid * 4 + 3]);
            __hip_atomic_store(slots + ((size_t)(u.pm * BM + tid) * 4 + u.pn), t, __ATOMIC_RELAXED, __HIP_MEMORY_SCOPE_AGENT);
            asm volatile("s_waitcnt vmcnt(0)" ::: "memory");
            if (lane == 0) (void)__hip_atomic_fetch_add(pc, 1u, __ATOMIC_RELAXED, __HIP_MEMORY_SCOPE_AGENT); }
        if (tid < 64) { unsigned sp = 0;
            while (__hip_atomic_load(pc, __ATOMIC_RELAXED, __HIP_MEMORY_SCOPE_AGENT) < 16u) { __builtin_amdgcn_s_sleep(1); if (++sp > (1u << 22)) break; }
            __builtin_amdgcn_fence(__ATOMIC_ACQUIRE, "agent"); asm volatile("s_waitcnt vmcnt(0)" ::: "memory"); }
        __syncthreads();
        if (tid < 256) { const float* sl = slots + (size_t)(u.pm * BM + tid) * 4; float t = 0.f;
#pragma unroll
            for (int k = 0; k < 4; ++k) t += __hip_atomic_load(sl + k, __ATOMIC_RELAXED, __HIP_MEMORY_SCOPE_AGENT);
            S[tid] = w * rsqrtf(t * (1.f / D) + EPS); }
        __syncthreads();
        const size_t ub = (size_t)u.pm * BM * D + u.pn * BM + wc * 32; const bf16_t* hb = H + ub; float* ssb = ssout + u.pm * BM;
        f32x4 gv[2][2];
#pragma unroll
        for (int bj = 0; bj < 2; ++bj)
#pragma unroll
            for (int n = 0; n < 2; ++n) gv[bj][n] = *(const f32x4*)(g + u.pn * BM + wc * 32 + bj * HALF + 8 * fq + 4 * n);
        u32x4 hn[2];
        { const unsigned off = (unsigned)(r0 * D + 8 * fq);
#pragma unroll
          for (int bj = 0; bj < 2; ++bj) hn[bj] = *(const u32x4*)(hb + off + bj * HALF); }
#pragma unroll
        for (int ai = 0; ai < 2; ++ai)
#pragma unroll
            for (int m = 0; m < 4; ++m) { const int rl = r0 + ai * HALF + m * 16; const unsigned off = (unsigned)(rl * D + 8 * fq); const float s = S[rl];
                u32x4 hw[2]; float q = 0.f;
#pragma unroll
                for (int bj = 0; bj < 2; ++bj) hw[bj] = hn[bj];
                if (!(ai == 1 && m == 3)) { const int rn = r0 + (m == 3 ? HALF : ai * HALF + (m + 1) * 16); const unsigned offn = (unsigned)(rn * D + 8 * fq);
#pragma unroll
                    for (int bj = 0; bj < 2; ++bj) hn[bj] = *(const u32x4*)(hb + offn + bj * HALF); }
#pragma unroll
                for (int bj = 0; bj < 2; ++bj) { const u32x4 h = hw[bj]; const f32x4 a0 = acc[ai][bj][m][0] * s * gv[bj][0], a1 = acc[ai][bj][m][1] * s * gv[bj][1];
                    f32x4 o0, o1; o0[0] = bf_lo(h.x) + a0[0]; o0[1] = bf_hi(h.x) + a0[1]; o0[2] = bf_lo(h.y) + a0[2]; o0[3] = bf_hi(h.y) + a0[3];
                    o1[0] = bf_lo(h.z) + a1[0]; o1[1] = bf_hi(h.z) + a1[1]; o1[2] = bf_lo(h.w) + a1[2]; o1[3] = bf_hi(h.w) + a1[3];
                    if (FINAL) { *(f32x4*)(out + ub + off + bj * HALF) = o0; *(f32x4*)(out + ub + off + bj * HALF + 4) = o1; }
                    else { q += (o0[0] * o0[0] + o0[1] * o0[1]) + (o0[2] * o0[2] + o0[3] * o0[3]) + (o1[0] * o1[0] + o1[1] * o1[1]) + (o1[2] * o1[2] + o1[3] * o1[3]);
                        u32x4 wv; wv.x = cvt_pk_bf16(o0[0], o0[1]); wv.y = cvt_pk_bf16(o0[2], o0[3]); wv.z = cvt_pk_bf16(o1[0], o1[1]); wv.w = cvt_pk_bf16(o1[2], o1[3]);
                        *(u32x4*)(dst + ub + off + bj * HALF) = wv; } }
                if (!FINAL) { q += __shfl_xor(q, 16); q += __shfl_xor(q, 32); if (fq == 0) atomic_addf(ssb + rl, q); }
                EPI_FENCE(); }
    }
};
}

namespace att {
using bf16 = __hip_bfloat16;
constexpr float SCALE = 0.10206207261596575f;
constexpr float THR = 8.f;
constexpr int NW = 8, QBLK = 32, KVBLK = 64, QB = NW * QBLK, NQB = SEQ / QB, OP = NHEAD * DVH;
constexpr int SHM_V = KVBLK * 128 * 2, SHM_K = KVBLK * 128 * 2;
constexpr int LDS_BYTES = 3 * SHM_V + 3 * SHM_K + NW * 64 * 4;
#define KSWZ(row, colB) ((row) * 256 + ((colB) ^ (((row) & 7) << 4)))
#define SBAR() __builtin_amdgcn_sched_barrier(0)
__device__ __forceinline__ int v_st(int k, int c) { const int kk = (k & ~0xC) | ((k & 4) << 1) | ((k & 8) >> 1); return ((kk >> 3) * 4 + (c >> 5)) * 512 + ((kk & 7) * 32 + (c & 31)) * 2; }
__device__ __forceinline__ int v_rd_base(int lane) { return ((lane & 3) << 3) | (((lane >> 2) & 3) << 6) | (((lane >> 4) & 1) << 5) | (((lane >> 5) & 1) << 8); }
constexpr int v_rd_off(int d0, int ks, int half) { return d0 * 512 + ks * 4096 + half * 2048; }
__device__ __forceinline__ int crow(int r, int hi) { return (r & 3) + 8 * (r >> 2) + 4 * hi; }
__device__ __forceinline__ unsigned cvtpk(float lo, float hi) { unsigned r; asm volatile("v_cvt_pk_bf16_f32 %0, %1, %2" : "=v"(r) : "v"(lo), "v"(hi)); return r; }
__device__ __forceinline__ bf16x8 load8(const bf16* p) { return *reinterpret_cast<const bf16x8*>(p); }
__device__ __forceinline__ void mask_tile(f32x16& p0, f32x16& p1, int dq) {
    const float NEG = -__builtin_inff();
#pragma unroll
    for (int r = 0; r < 16; ++r) {
        const int c = (r & 3) + 8 * (r >> 2);
        if (dq - c < 0) p0[r] = NEG;
        if (dq - c - 32 < 0) p1[r] = NEG;
    }
}
constexpr float THR2 = THR * 1.4426950408889634f;
template <bool FIRST>
__device__ __forceinline__ void partialSM(f32x16& p0, f32x16& p1, float& m_ref, f32x16& negm, float& alpha) {
    float pmax = p0[0];
#pragma unroll
    for (int r = 1; r < 16; ++r) pmax = fmaxf(pmax, p0[r]);
#pragma unroll
    for (int r = 0; r < 16; ++r) pmax = fmaxf(pmax, p1[r]);
    { auto rr = __builtin_amdgcn_permlane32_swap(__float_as_uint(pmax), __float_as_uint(pmax), false, false);
      pmax = fmaxf(__uint_as_float(rr[0]), __uint_as_float(rr[1])); }
    alpha = 1.f;
    if (FIRST || !__builtin_expect(__all(pmax <= THR2), 1)) {
        const float dl = FIRST ? pmax : fmaxf(pmax, 0.f); m_ref += dl; alpha = __builtin_amdgcn_exp2f(-dl);
#pragma unroll
        for (int r = 0; r < 16; ++r) { p0[r] -= dl; p1[r] -= dl; }
#pragma unroll
        for (int r = 0; r < 16; ++r) negm[r] = -m_ref;
    }
#pragma unroll
    for (int r = 0; r < 16; ++r) p0[r] = __builtin_amdgcn_exp2f(p0[r]);
}
__device__ __forceinline__ void finishSM(f32x16& p0, f32x16& p1, float alpha, float& l_reg, bf16x8& pa0, bf16x8& pa1, bf16x8& pa2, bf16x8& pa3) {
#pragma unroll
    for (int r = 0; r < 16; ++r) p1[r] = __builtin_amdgcn_exp2f(p1[r]);
    float ps = 0;
#pragma unroll
    for (int r = 0; r < 16; ++r) ps += p0[r];
#pragma unroll
    for (int r = 0; r < 16; ++r) ps += p1[r];
    { auto rr = __builtin_amdgcn_permlane32_swap(__float_as_uint(ps), __float_as_uint(ps), false, false);
      ps = __uint_as_float(rr[0]) + __uint_as_float(rr[1]); }
    l_reg = l_reg * alpha + ps;
#define PK4(P, B_, OUT) do { unsigned a0 = cvtpk(P[B_+0], P[B_+1]), a1 = cvtpk(P[B_+2], P[B_+3]);                          \
        unsigned b0 = cvtpk(P[B_+4], P[B_+5]), b1 = cvtpk(P[B_+6], P[B_+7]);                                             \
        auto r0 = __builtin_amdgcn_permlane32_swap(a0, b0, false, false); auto r1 = __builtin_amdgcn_permlane32_swap(a1, b1, false, false); \
        u32x4 w = {r0[0], r1[0], r0[1], r1[1]}; OUT = *reinterpret_cast<bf16x8*>(&w); } while (0)
    PK4(p0, 0, pa0); PK4(p0, 8, pa1); PK4(p1, 0, pa2); PK4(p1, 8, pa3);
#undef PK4
}
__device__ __forceinline__ void qkt(f32x16& p0, f32x16& p1, const char* Kbuf, int r32, int hi, const bf16x8* qr, const f32x16& negm) {
    p0 = negm; p1 = negm;
    const char* kb[4];
#pragma unroll
    for (int dd = 0; dd < 4; ++dd) kb[dd] = Kbuf + KSWZ(r32, (dd * 16 + hi * 8) * 2);
#pragma unroll
    for (int d0 = 0; d0 < 6; ++d0) { const char* a = kb[d0 & 3] + (d0 >> 2) * 128;
        bf16x8 b0 = *reinterpret_cast<const bf16x8*>(a);
        bf16x8 b1 = *reinterpret_cast<const bf16x8*>(a + 32 * 256);
        p0 = __builtin_amdgcn_mfma_f32_32x32x16_bf16(b0, qr[d0], p0, 0, 0, 0);
        p1 = __builtin_amdgcn_mfma_f32_32x32x16_bf16(b1, qr[d0], p1, 0, 0, 0); }
}
__device__ __forceinline__ void pv_tile(f32x16* o, int vb, bf16x8 pa0, bf16x8 pa1, bf16x8 pa2, bf16x8 pa3) {
#define TRRD(dst, off) asm volatile("ds_read_b64_tr_b16 %0, %1 offset:%2" : "=&v"(dst) : "v"(vb), "i"(off) : "memory")
#define PV_D0(d0) do { s16x4 l0, l1, l2, l3, h0, h1, h2, h3; constexpr int b_ = v_rd_off(d0, 0, 0); \
        TRRD(l0, b_); TRRD(h0, b_ + 2048); TRRD(l1, b_ + 4096); TRRD(h1, b_ + 6144); TRRD(l2, b_ + 8192); TRRD(h2, b_ + 10240); TRRD(l3, b_ + 12288); TRRD(h3, b_ + 14336); \
        asm volatile("s_waitcnt lgkmcnt(0)" ::: "memory"); SBAR();   \
        o[d0] = __builtin_amdgcn_mfma_f32_32x32x16_bf16(pa0, (bf16x8){l0[0], l0[1], l0[2], l0[3], h0[0], h0[1], h0[2], h0[3]}, o[d0], 0, 0, 0);   \
        o[d0] = __builtin_amdgcn_mfma_f32_32x32x16_bf16(pa1, (bf16x8){l1[0], l1[1], l1[2], l1[3], h1[0], h1[1], h1[2], h1[3]}, o[d0], 0, 0, 0);   \
        o[d0] = __builtin_amdgcn_mfma_f32_32x32x16_bf16(pa2, (bf16x8){l2[0], l2[1], l2[2], l2[3], h2[0], h2[1], h2[2], h2[3]}, o[d0], 0, 0, 0);   \
        o[d0] = __builtin_amdgcn_mfma_f32_32x32x16_bf16(pa3, (bf16x8){l3[0], l3[1], l3[2], l3[3], h3[0], h3[1], h3[2], h3[3]}, o[d0], 0, 0, 0); } while (0)
    PV_D0(0); PV_D0(1);
#undef PV_D0
#undef TRRD
}
struct BlockRef { const bf16* Q; const bf16* K; const bf16* V; bf16* O; int P0; };
struct Seam { bf16x8 qr[6]; bf16x8 st_v0, st_k0, st_k1; int rot; };
#define VMW() asm volatile("s_waitcnt vmcnt(0)" ::: "memory")
#define SLOAD_H(Kp, Vp, k0) do { S.st_v0 = load8((Vp) + (size_t)((k0) + vk) * DVH + vc); \
        if (kact) { S.st_k0 = load8((Kp) + (size_t)((k0) + sr) * DQK + sc); S.st_k1 = load8((Kp) + (size_t)((k0) + 32 + sr) * DQK + sc); } } while (0)
#define SWRITE_H(bf) do { *(bf16x8*)(V_lds + (bf) * SHM_V + vst0) = S.st_v0; \
        if (kact) { *(bf16x8*)(K_lds + (bf) * SHM_K + kws) = S.st_k0; *(bf16x8*)(K_lds + (bf) * SHM_K + kws + 32 * 256) = S.st_k1; } } while (0)
__device__ __forceinline__ void prime(const BlockRef& cur, char* lds, Seam& S) {
    const int tid = threadIdx.x, wid = __builtin_amdgcn_readfirstlane(tid >> 6), lane = tid & 63, r32 = lane & 31, hi = lane >> 5;
    const int sr = tid >> 4, sc = (tid & 15) * 8, kws = KSWZ(sr, sc * 2); const bool kact = sc < DQK; const int vk = tid >> 3, vc = (tid & 7) * 8, vst0 = v_st(vk, vc);
    char* V_lds = lds; char* K_lds = lds + 3 * SHM_V;
#pragma unroll
    for (int d0 = 0; d0 < 6; ++d0) S.qr[d0] = load8(cur.Q + (size_t)(wid * QBLK + r32) * DQK + d0 * 16 + hi * 8);
    SLOAD_H(cur.K, cur.V, 0); VMW(); SWRITE_H(0); SBAR();
    SLOAD_H(cur.K, cur.V, KVBLK);
    S.rot = 0;
    __syncthreads();
}
__device__ __forceinline__ void block(const BlockRef& cur, const BlockRef& nxt, char* lds, Seam& S) {
    const int tid = threadIdx.x, wid = __builtin_amdgcn_readfirstlane(tid >> 6), lane = tid & 63, r32 = lane & 31, hi = lane >> 5;
    const int NT = (cur.P0 + QB) / KVBLK;
    const int qlo = cur.P0 + wid * QBLK, qm = qlo + r32 - 4 * hi;
    char* V_lds = lds; char* K_lds = lds + 3 * SHM_V;
    float* ws = (float*)(lds + 3 * SHM_V + 3 * SHM_K) + wid * 64; float* li_l = ws, * al_l = ws + 32;
    float m_reg = 0.f, l_reg = 0; f32x16 o[2] = {}; f32x16 negm = {};
    const int sr = tid >> 4, sc = (tid & 15) * 8, kws = KSWZ(sr, sc * 2); const bool kact = sc < DQK;
    const int vk = tid >> 3, vc = (tid & 7) * 8, vst0 = v_st(vk, vc);
    const int vb0 = (int)(uintptr_t)V_lds + v_rd_base(lane);
    const bf16* Kh = cur.K; const bf16* Vh = cur.V;
    int rot = S.rot;
#define RESC(a) do { if (__any((a) < 1.f)) { if (hi == 0) al_l[r32] = (a); asm volatile("s_waitcnt lgkmcnt(0)" ::: "memory");              \
                     for (int d_ = 0; d_ < 2; ++d_) for (int r = 0; r < 16; ++r) o[d_][r] *= al_l[crow(r, hi)]; } } while (0)
#define MASKT(P0_, P1_, t) do { const int kb_ = (t) * KVBLK; if (kb_ + KVBLK - 1 > qlo) mask_tile(P0_, P1_, qm - kb_); } while (0)
    f32x16 pA0, pA1, pB0, pB1; float alA, alB; bf16x8 pa0, pa1, pa2, pa3;
#define STEP(PX0, PX1, mnX, alX, PY0, PY1, alY, t, HAS_PREV) do {                                                             \
        const int bn_ = rot == 2 ? 0 : rot + 1, bp_ = rot == 0 ? 2 : rot - 1;                                                 \
        VMW(); SWRITE_H(bn_); SBAR();                                                                                          \
        { const int tt_ = (t) + 2; const bool in_ = tt_ < NT; const bf16* Kp_ = in_ ? Kh : nxt.K; const bf16* Vp_ = in_ ? Vh : nxt.V; \
          const int k0_ = (in_ ? tt_ : tt_ - NT) * KVBLK; SLOAD_H(Kp_, Vp_, k0_); } SBAR();                                    \
        qkt(PX0, PX1, K_lds + rot * SHM_K, r32, hi, S.qr, negm);                                                               \
        if (HAS_PREV) { finishSM(PY0, PY1, alY, l_reg, pa0, pa1, pa2, pa3); SBAR();                                           \
                        pv_tile(o, vb0 + bp_ * SHM_V, pa0, pa1, pa2, pa3); }                                                   \
        MASKT(PX0, PX1, (t)); partialSM<!(HAS_PREV)>(PX0, PX1, m_reg, negm, alX);                                              \
        RESC(alX); __syncthreads(); rot = bn_; } while (0)
    STEP(pA0, pA1, mnA, alA, pB0, pB1, alB, 0, false);
    STEP(pB0, pB1, mnB, alB, pA0, pA1, alA, 1, true);
    for (int t = 2; t < NT; t += 2) {
        STEP(pA0, pA1, mnA, alA, pB0, pB1, alB, t, true);
        STEP(pB0, pB1, mnB, alB, pA0, pA1, alA, t + 1, true);
    }
#pragma unroll
    for (int d0 = 0; d0 < 6; ++d0) S.qr[d0] = load8(nxt.Q + (size_t)(wid * QBLK + r32) * DQK + d0 * 16 + hi * 8);
    SBAR();
    finishSM(pB0, pB1, alB, l_reg, pa0, pa1, pa2, pa3); SBAR();
    pv_tile(o, vb0 + (rot == 0 ? 2 : rot - 1) * SHM_V, pa0, pa1, pa2, pa3);
    S.rot = rot;
    if (hi == 0) li_l[r32] = l_reg; asm volatile("s_waitcnt lgkmcnt(0)" ::: "memory");
    float rli[16];
#pragma unroll
    for (int r = 0; r < 16; ++r) rli[r] = __builtin_amdgcn_rcpf(li_l[crow(r, hi)]);
    bf16* Ow = cur.O + (size_t)(wid * QBLK) * OP;
#pragma unroll
    for (int r = 0; r < 16; ++r) { const int orow = crow(r, hi);
#pragma unroll
        for (int d0 = 0; d0 < 2; ++d0) { const float v = o[d0][r] * rli[r];
            const float vn = __shfl_xor(v, 1);
            if ((r32 & 1) == 0) *(unsigned*)(Ow + (size_t)orow * OP + d0 * 32 + r32) = cvtpk(v, vn); } }
#undef RESC
#undef MASKT
#undef STEP
}
#undef VMW
#undef SLOAD_H
#undef SWRITE_H
__device__ __forceinline__ BlockRef mkref(int idx, const bf16* Q, const bf16* K, const bf16* V, bf16* O) {
    const int item = idx >> 1, pass = idx & 1, bh = item >> 5, x = item & 31, qb = pass ? (NQB - 1 - x) : x, b = bh >> 3, h = bh & 7;
    BlockRef r;
    r.Q = Q + ((size_t)bh * SEQ + (size_t)qb * QB) * DQK; r.K = K + (size_t)bh * SEQ * DQK; r.V = V + (size_t)bh * SEQ * DVH;
    r.O = O + ((size_t)b * SEQ + (size_t)qb * QB) * OP + h * DVH; r.P0 = qb * QB;
    return r;
}
__device__ __forceinline__ void attn_phase(char* lds, const bf16* Q, const bf16* K, const bf16* V, bf16* O) {
    constexpr int NITEMS = NB * NHEAD * (NQB / 2);
    const int G = gridDim.x;
    int it = blockIdx.x;
    if (it < NITEMS) {
        int idx = it * 2;
        BlockRef cur = mkref(idx, Q, K, V, O);
        Seam S;
        prime(cur, lds, S);
        for (;;) {
            int nidx;
            if ((idx & 1) == 0) nidx = idx + 1; else { const int nit = (idx >> 1) + G; nidx = nit < NITEMS ? nit * 2 : -1; }
            const bool last = nidx < 0;
            const BlockRef nxt = last ? cur : mkref(nidx, Q, K, V, O);
            block(cur, nxt, lds, S);
            if (last) break;
            cur = nxt; idx = nidx;
        }
    }
}
#undef KSWZ
#undef SBAR
}

#define XB_TMO      128
#define XB_XCNT(j)  (256  + 64 * (j))
#define XB_XSUB(j)  (1280 + 64 * (j))
#define XB_XGEN(j)  (2304 + 64 * (j))
#define XB_TOP      3328
#define XB_TOPGEN   3392
#define XCD_BAR_WORDS 3456
#define XB_SPIN_CAP (1u << 18)

__device__ __forceinline__ unsigned xb_ld(unsigned* p)              { return __hip_atomic_load(p, __ATOMIC_RELAXED, __HIP_MEMORY_SCOPE_AGENT); }
__device__ __forceinline__ unsigned xb_add(unsigned* p, unsigned v) { return __hip_atomic_fetch_add(p, v, __ATOMIC_RELAXED, __HIP_MEMORY_SCOPE_AGENT); }
__device__ __forceinline__ unsigned xb_xcc_id() { return (unsigned)__builtin_amdgcn_s_getreg((3 << 11) | 20) & 0xFu; }
#define XB_SPIN(cond, bar) do { unsigned _sp = 0; while (cond) { __builtin_amdgcn_s_sleep(1); \
    if ((++_sp & 255u) == 0u) { if (xb_ld(&(bar)[XB_TMO])) break; if (_sp > XB_SPIN_CAP) { atomicAdd(&(bar)[XB_TMO], 1u); break; } } } } while (0)

struct XcdBarrier {
    unsigned* bar; unsigned x;
    volatile LAS unsigned* st;
};

__device__ __forceinline__ XcdBarrier xcd_barrier_post(unsigned* bar, volatile LAS unsigned* st) {
    XcdBarrier b; b.bar = bar; b.x = xb_xcc_id(); b.st = st;
    if (threadIdx.x == 0) (void)xb_add(&bar[XB_XCNT(b.x)], 1u);
    return b;
}
__device__ __forceinline__ void xcd_barrier_complete(unsigned* bar, unsigned x, unsigned& nloc, unsigned& nx) {
    const unsigned G = gridDim.x * gridDim.y * gridDim.z;
    unsigned sum, cnt, mine, sp = 0u;
    for (;;) {
        sum = 0u; cnt = 0u; mine = 0u;
#pragma unroll
        for (unsigned j = 0; j < 16; ++j) { const unsigned c = xb_ld(&bar[XB_XCNT(j)]); sum += c; cnt += (c > 0u) ? 1u : 0u; mine = (j == x) ? c : mine; }
        if (sum == G) break;
        __builtin_amdgcn_s_sleep(1);
        if ((++sp & 255u) == 0u) { if (xb_ld(&bar[XB_TMO])) break; if (sp > XB_SPIN_CAP) { atomicAdd(&bar[XB_TMO], 1u); break; } }
    }
    nloc = mine > 0u ? mine : 1u; nx = cnt > 0u ? cnt : 1u;
}

__device__ __forceinline__ void xcd_barrier(const XcdBarrier& b) {
    asm volatile("s_waitcnt vmcnt(0)" ::: "memory");
    __syncthreads();
    if (threadIdx.x == 0) {
        unsigned* bar = b.bar;
        __builtin_amdgcn_s_waitcnt(0);
        unsigned nloc = b.st[0], nx = b.st[1];
        if (nloc == 0u) { xcd_barrier_complete(bar, b.x, nloc, nx); b.st[0] = nloc; b.st[1] = nx; }
        const unsigned old = xb_add(&bar[XB_XSUB(b.x)], 1u);
        const unsigned gen = old / nloc;
        if (old + 1u == (gen + 1u) * nloc) {
            __builtin_amdgcn_fence(__ATOMIC_RELEASE, "agent");
            asm volatile("s_waitcnt vmcnt(0)" ::: "memory");
            const unsigned og = xb_add(&bar[XB_TOP], 1u);
            const unsigned tg = og / nx;
            if (og + 1u == (tg + 1u) * nx) xb_add(&bar[XB_TOPGEN], 1u);
            else XB_SPIN(xb_ld(&bar[XB_TOPGEN]) == tg, bar);
            __builtin_amdgcn_fence(__ATOMIC_ACQUIRE, "agent");
            xb_add(&bar[XB_XGEN(b.x)], 1u);
            asm volatile("s_waitcnt vmcnt(0)" ::: "memory");
        } else {
            XB_SPIN(xb_ld(&bar[XB_XGEN(b.x)]) == gen, bar);
            __builtin_amdgcn_fence(__ATOMIC_ACQUIRE, "agent");
            asm volatile("s_waitcnt vmcnt(0)" ::: "memory");
        }
    }
    __syncthreads();
}


constexpr int RING_BYTES = 131072, LDS_BYTES = 147456;
static_assert(att::LDS_BYTES <= RING_BYTES, "attention scratch fits the ring region");

static __device__ const double kInvFreq[16] = {1.0, 0.5623413251903491, 0.31622776601683794, 0.1778279410038923, 0.1, 0.05623413251903491, 0.03162277660168379, 0.01778279410038923, 0.01, 0.005623413251903491, 0.0031622776601683794, 0.0017782794100389228, 0.001, 0.0005623413251903491, 0.00031622776601683794, 0.00017782794100389227};
struct Args { const float* in[29]; float* out; unsigned char* ws; int ph_lo, ph_hi; };
enum { I_X = 0, I_POS, I_F1PRE, I_F1G, I_F1U, I_F1D, I_F1POST, I_MIXPRE, I_WIN, I_QNG, I_WUQ, I_KVNG, I_WUKV, I_WOMLA, I_CONVW, I_CONVB, I_WRG, I_BRG, I_WIG, I_BIG, I_LAMBDA, I_WOLRU, I_WOUT, I_MIXPOST,
       I_F2PRE, I_F2G, I_F2U, I_F2D, I_F2POST };

__device__ __forceinline__ unsigned f2bf(float f) { unsigned u = __builtin_bit_cast(unsigned, f); return (u + 0x7fffu + ((u >> 16) & 1u)) >> 16; }
__device__ __forceinline__ unsigned pk2(float lo, float hi) { return f2bf(lo) | (f2bf(hi) << 16); }
#define LDS_WAIT() asm volatile("s_waitcnt lgkmcnt(0)" ::: "memory")

__device__ __forceinline__ void tr_item(const float* W, int ld, int c0, int K, int ncols, bf16_t* WT, int row_off, int il, const float* gv, LAS float* scr, int item, int lane) {
    const int nblk = ncols / 32, kb = item / nblk, nb = item % nblk, k0 = 64 * kb, n0 = 32 * nb;
#pragma unroll
    for (int i = 0; i < 32; ++i) { const int kk = 2 * i + (lane >> 5); float v = W[(size_t)(k0 + kk) * ld + c0 + n0 + (lane & 31)]; if (gv) v *= gv[k0 + kk]; scr[kk * 33 + (lane & 31)] = v; }
    LDS_WAIT(); asm volatile("" ::: "memory");
    const int c = lane & 7;
#pragma unroll
    for (int j = 0; j < 4; ++j) { const int n = (lane >> 3) + 8 * j, nn = n0 + n; const int drow = row_off + (il < 0 ? nn : ((nn >> 7) * 256 + (nn & 127) + 128 * il));
        const LAS float* s = scr + (8 * c) * 33 + n;
        u32x4 o; o.x = pk2(s[0 * 33], s[1 * 33]); o.y = pk2(s[2 * 33], s[3 * 33]); o.z = pk2(s[4 * 33], s[5 * 33]); o.w = pk2(s[6 * 33], s[7 * 33]);
        *(u32x4*)(WT + (size_t)drow * K + k0 + 8 * c) = o; }
    LDS_WAIT(); asm volatile("" ::: "memory");
}

__global__ void __launch_bounds__(512, 2) mega_fwd(Args args) {
    extern __shared__ __attribute__((aligned(16))) unsigned char lds[];
    cg::grid_group grid = cg::this_grid();
    const int tid = threadIdx.x, lane = tid & 63, wave = __builtin_amdgcn_readfirstlane(tid >> 6);
    const int G = gridDim.x, gw = blockIdx.x * 8 + wave, NGW = G * 8;
    unsigned char* ws = args.ws;
    LAS unsigned char* ldsl = (LAS unsigned char*)lds;
    const float* x = args.in[I_X]; float* out = args.out;
    float* SSY1 = (float*)(ws + WS_SSY1); float* SSQ = (float*)(ws + WS_SSQ); float* SSKV = (float*)(ws + WS_SSKV); float* SSZ = (float*)(ws + WS_SSZ); float* SSY2 = (float*)(ws + WS_SSY2);
    float* RS0 = (float*)(ws + WS_RS0); float* RS1 = (float*)(ws + WS_RS1); float* RS2 = (float*)(ws + WS_RS2); float* NLA = (float*)(ws + WS_NLA);
    float* CS = (float*)(ws + WS_CS); float* PS = (float*)(ws + WS_PS);
    bf16_t* Wgu1 = (bf16_t*)(ws + WS_WGU1); bf16_t* Wd1 = (bf16_t*)(ws + WS_WD1); bf16_t* Wgu2 = (bf16_t*)(ws + WS_WGU2); bf16_t* Wd2 = (bf16_t*)(ws + WS_WD2);
    bf16_t* Win = (bf16_t*)(ws + WS_WIN); bf16_t* Wuq = (bf16_t*)(ws + WS_WUQ); bf16_t* Wukv = (bf16_t*)(ws + WS_WUKV); bf16_t* Wm = (bf16_t*)(ws + WS_WM); bf16_t* Wl = (bf16_t*)(ws + WS_WL);
    bf16_t* Wo = (bf16_t*)(ws + WS_WO); bf16_t* Wgate = (bf16_t*)(ws + WS_WGATE);
    bf16_t* Y = (bf16_t*)(ws + WS_Y); bf16_t* XN = (bf16_t*)(ws + WS_XN); bf16_t* ACT = (bf16_t*)(ws + WS_ACT); bf16_t* LAT = (bf16_t*)(ws + WS_LAT);
    bf16_t* XB = (bf16_t*)(ws + WS_XB); bf16_t* GY = (bf16_t*)(ws + WS_GY); bf16_t* SA = (bf16_t*)(ws + WS_SA); bf16_t* SB = (bf16_t*)(ws + WS_SB); bf16_t* LA = (bf16_t*)(ws + WS_LA);
    bf16_t* Qb = (bf16_t*)(ws + WS_Q); bf16_t* Kb = (bf16_t*)(ws + WS_K); bf16_t* Vb = (bf16_t*)(ws + WS_V); bf16_t* Ob = (bf16_t*)(ws + WS_O); bf16_t* MG = (bf16_t*)(ws + WS_MG); bf16_t* Zb = (bf16_t*)(ws + WS_Z);
    const int lo = args.ph_lo, hi = args.ph_hi;
#ifndef PHMASK
#define PHMASK 0x1FFFF
#endif
#define IN(k) (((PHMASK >> (k)) & 1) && lo <= (k) && (k) < hi)
    volatile LAS unsigned* bst = (volatile LAS unsigned*)(ldsl + RING_BYTES + 64);
    if (tid == 0) { bst[0] = 0u; bst[1] = 0u; }
    __syncthreads();
    XcdBarrier xbar; xbar.bar = (unsigned*)(ws + WS_BAR); xbar.x = 0; xbar.st = bst;
    xbar = xcd_barrier_post((unsigned*)(ws + WS_BAR), bst);
    if (lo < 0) grid.sync();
#define SEAM(k) do { if (IN(k) && IN((k) + 1)) xcd_barrier(xbar); } while (0)

    if (IN(0)) {
        LAS float* scr = (LAS float*)(ldsl + wave * 16384);
        constexpr int I_GU = (D / 64) * (DFF / 32), I_DN = (DFF / 64) * (D / 32), I_WIN0 = (D / 64) * (672 / 32), I_WIN1 = (D / 64) * (4096 / 32), I_UQ = (QLORA / 64) * (768 / 32),
                      I_UKV = (KVLORA / 64) * (1024 / 32), I_M = (512 / 64) * (D / 32), I_SQ = (D / 64) * (D / 32), I_GT = 8 * (128 / 64) * (128 / 32);
        constexpr int NITEMS = 4 * I_GU + 2 * I_DN + I_WIN0 + I_WIN1 + I_UQ + I_UKV + I_M + 2 * I_SQ + 2 * I_GT;
        for (int it = gw; it < NITEMS; it += NGW) {
            int r = it;
            if (r < I_GU) { tr_item(args.in[I_F1G], DFF, 0, D, DFF, Wgu1, 0, 0, args.in[I_F1PRE], scr, r, lane); continue; } r -= I_GU;
            if (r < I_GU) { tr_item(args.in[I_F1U], DFF, 0, D, DFF, Wgu1, 0, 1, args.in[I_F1PRE], scr, r, lane); continue; } r -= I_GU;
            if (r < I_DN) { tr_item(args.in[I_F1D], D, 0, DFF, D, Wd1, 0, -1, nullptr, scr, r, lane); continue; } r -= I_DN;
            if (r < I_GU) { tr_item(args.in[I_F2G], DFF, 0, D, DFF, Wgu2, 0, 0, args.in[I_F2PRE], scr, r, lane); continue; } r -= I_GU;
            if (r < I_GU) { tr_item(args.in[I_F2U], DFF, 0, D, DFF, Wgu2, 0, 1, args.in[I_F2PRE], scr, r, lane); continue; } r -= I_GU;
            if (r < I_DN) { tr_item(args.in[I_F2D], D, 0, DFF, D, Wd2, 0, -1, nullptr, scr, r, lane); continue; } r -= I_DN;
            if (r < I_WIN0) { tr_item(args.in[I_WIN], 4768, 0, D, 672, Win, 0, -1, args.in[I_MIXPRE], scr, r, lane); continue; } r -= I_WIN0;
            if (r < I_WIN1) { tr_item(args.in[I_WIN], 4768, 672, D, 4096, Win, 768, -1, args.in[I_MIXPRE], scr, r, lane); continue; } r -= I_WIN1;
            if (r < I_UQ) { tr_item(args.in[I_WUQ], 768, 0, QLORA, 768, Wuq, 0, -1, args.in[I_QNG], scr, r, lane); continue; } r -= I_UQ;
            if (r < I_UKV) { tr_item(args.in[I_WUKV], 1024, 0, KVLORA, 1024, Wukv, 0, -1, args.in[I_KVNG], scr, r, lane); continue; } r -= I_UKV;
            if (r < I_M) { tr_item(args.in[I_WOMLA], D, 0, 512, D, Wm, 0, -1, nullptr, scr, r, lane); continue; } r -= I_M;
            if (r < I_SQ) { tr_item(args.in[I_WOLRU], D, 0, D, D, Wl, 0, -1, nullptr, scr, r, lane); continue; } r -= I_SQ;
            if (r < I_SQ) { tr_item(args.in[I_WOUT], D, 0, D, D, Wo, 0, -1, nullptr, scr, r, lane); continue; } r -= I_SQ;
            if (r < I_GT) { const int g = r >> 3; tr_item(args.in[I_WRG] + (size_t)g * 16384, 128, 0, 128, 128, Wgate + (size_t)g * 32768, 0, 0, nullptr, scr, r & 7, lane); continue; } r -= I_GT;
            { const int g = r >> 3; tr_item(args.in[I_WIG] + (size_t)g * 16384, 128, 0, 128, 128, Wgate + (size_t)g * 32768, 0, 1, nullptr, scr, r & 7, lane); }
        }
        for (int i = blockIdx.x * 512 + tid; i < 96 * D / 8; i += G * 512) *(u32x4*)(Win + (size_t)672 * D + (size_t)i * 8) = (u32x4){0u, 0u, 0u, 0u};
        for (int m0 = gw; m0 < M; m0 += 2 * NGW) {
            const bool two = m0 + NGW < M; const int mm[2] = {m0, two ? m0 + NGW : m0}; f32x4 v[2][4]; float sv[2];
#pragma unroll
            for (int r = 0; r < 2; ++r)
#pragma unroll
                for (int j = 0; j < 4; ++j) v[r][j] = ((const f32x4*)(x + (size_t)mm[r] * D) + lane)[64 * j];
#pragma unroll
            for (int r = 0; r < 2; ++r) { float s = 0.f;
#pragma unroll
                for (int j = 0; j < 4; ++j) s += (v[r][j][0] * v[r][j][0] + v[r][j][1] * v[r][j][1]) + (v[r][j][2] * v[r][j][2] + v[r][j][3] * v[r][j][3]);
                sv[r] = wave_sum(s); }
#pragma unroll
            for (int r = 0; r < 2; ++r) if (r == 0 || two) { const int m = mm[r]; u32x2* o8 = (u32x2*)(XN + (size_t)m * D) + lane;
#pragma unroll
                for (int j = 0; j < 4; ++j) { u32x2 w; w.x = cvt_pk_bf16(v[r][j][0], v[r][j][1]); w.y = cvt_pk_bf16(v[r][j][2], v[r][j][3]); o8[64 * j] = w; }
                if (lane == 0) { RS0[m] = rsqrtf(sv[r] * (1.f / D) + EPS); SSY1[m] = 0.f; SSQ[m] = 0.f; SSKV[m] = 0.f; SSZ[m] = 0.f; SSY2[m] = 0.f; } }
        }
        { const int* pos = (const int*)args.in[I_POS];
          for (int i = blockIdx.x * 512 + tid; i < M * 16; i += G * 512) { const int row = i >> 4, f = i & 15;
              const double ang = (double)pos[row] * kInvFreq[f]; const double kq = rint(ang * 0.15915494309189535);
              const float rf = (float)fma(-kq, 6.283185307179586, ang); float sn, cn; sincosf(rf, &sn, &cn);
              CS[(size_t)row * 32 + f] = cn; CS[(size_t)row * 32 + 16 + f] = sn; } }
        for (int i = blockIdx.x * 512 + tid; i < D; i += G * 512) { const float l = args.in[I_LAMBDA][i]; NLA[i] = -8.f * log1pf(expf(-l)); }
    }
    SEAM(0);
    if (IN(1)) { pg8::Gemm g{XN, Wgu1, M, 2 * DFF, D, D, 0}; pg8::StaticOrder S; S.init(M, 2 * DFF, G, (int)blockIdx.x);
        pg8::EpiSwiGLU E{ACT, DFF, RS0, false}; pg8::gemm_phase(ldsl, g, S, E); }
    SEAM(1);
    if (IN(2)) { pg8::Gemm g{ACT, Wd1, M, D, DFF, DFF, 0}; pg8::StaticOrder S; S.init(M, D, G, (int)blockIdx.x);
        pg8::EpiBfSS E{Y, D, SSY1}; pg8::gemm_phase(ldsl, g, S, E); }
    SEAM(2);
    if (IN(3)) {
        f32x4 gv[4];
#pragma unroll
        for (int j = 0; j < 4; ++j) gv[j] = ((const f32x4*)args.in[I_F1POST])[lane + 64 * j];
        for (int m0 = gw; m0 < M; m0 += 2 * NGW) {
            const bool two = m0 + NGW < M; const int mm[2] = {m0, two ? m0 + NGW : m0}; u32x2 xw[2][4], yw[2][4]; f32x4 v[2][4]; float rsy[2], sv[2];
#pragma unroll
            for (int r = 0; r < 2; ++r) { rsy[r] = SSY1[mm[r]];
#pragma unroll
                for (int j = 0; j < 4; ++j) { xw[r][j] = ((const u32x2*)(XN + (size_t)mm[r] * D) + lane)[64 * j]; yw[r][j] = ((const u32x2*)(Y + (size_t)mm[r] * D) + lane)[64 * j]; } }
#pragma unroll
            for (int r = 0; r < 2; ++r) { const float ry = 0.5f * rsqrtf(rsy[r] * (1.f / D) + EPS); float s = 0.f;
#pragma unroll
                for (int j = 0; j < 4; ++j) { f32x4& h = v[r][j]; h[0] = bf_lo(xw[r][j].x) + bf_lo(yw[r][j].x) * ry * gv[j][0]; h[1] = bf_hi(xw[r][j].x) + bf_hi(yw[r][j].x) * ry * gv[j][1];
                    h[2] = bf_lo(xw[r][j].y) + bf_lo(yw[r][j].y) * ry * gv[j][2]; h[3] = bf_hi(xw[r][j].y) + bf_hi(yw[r][j].y) * ry * gv[j][3];
                    s += (h[0] * h[0] + h[1] * h[1]) + (h[2] * h[2] + h[3] * h[3]); }
                sv[r] = wave_sum(s); }
#pragma unroll
            for (int r = 0; r < 2; ++r) if (r == 0 || two) { const int m = mm[r]; u32x2* o8 = (u32x2*)(Y + (size_t)m * D) + lane;
#pragma unroll
                for (int j = 0; j < 4; ++j) { u32x2 w; w.x = cvt_pk_bf16(v[r][j][0], v[r][j][1]); w.y = cvt_pk_bf16(v[r][j][2], v[r][j][3]); o8[64 * j] = w; }
                if (lane == 0) RS1[m] = rsqrtf(sv[r] * (1.f / D) + EPS); }
        }
    }
    SEAM(3);
    if (IN(4)) { pg8::Gemm g{Y, Win, M, NWIN, D, D, 0}; pg8::StaticOrder S; S.init(M, NWIN, G, (int)blockIdx.x);
        pg8::EpiWin E{LAT, XB, RS1, SSQ, SSKV}; pg8::gemm_phase(ldsl, g, S, E); }
    SEAM(4);
    if (IN(5)) {
        const float* cw = args.in[I_CONVW]; const float* cb = args.in[I_CONVB];
        const int cgp = tid & 127, stream = tid >> 7, ch0 = cgp * 8;
        float w[4][8], bsv[8];
#pragma unroll
        for (int j = 0; j < 4; ++j)
#pragma unroll
            for (int i = 0; i < 8; ++i) w[j][i] = cw[j * D + ch0 + i];
#pragma unroll
        for (int i = 0; i < 8; ++i) bsv[i] = cb[ch0 + i];
        constexpr int RUN = 16;
        for (int run = blockIdx.x * 4 + stream; run < M / RUN; run += G * 4) {
            const int r0 = run * RUN; const bool start = (r0 % SEQ) == 0;
            float h0[8], h1[8], h2[8];
            { u32x4 a = {0u, 0u, 0u, 0u}, b = a, c = a;
              if (!start) { a = *(const u32x4*)(XB + (size_t)(r0 - 3) * D + ch0); b = *(const u32x4*)(XB + (size_t)(r0 - 2) * D + ch0); c = *(const u32x4*)(XB + (size_t)(r0 - 1) * D + ch0); }
              h0[0] = bf_lo(a.x); h0[1] = bf_hi(a.x); h0[2] = bf_lo(a.y); h0[3] = bf_hi(a.y); h0[4] = bf_lo(a.z); h0[5] = bf_hi(a.z); h0[6] = bf_lo(a.w); h0[7] = bf_hi(a.w);
              h1[0] = bf_lo(b.x); h1[1] = bf_hi(b.x); h1[2] = bf_lo(b.y); h1[3] = bf_hi(b.y); h1[4] = bf_lo(b.z); h1[5] = bf_hi(b.z); h1[6] = bf_lo(b.w); h1[7] = bf_hi(b.w);
              h2[0] = bf_lo(c.x); h2[1] = bf_hi(c.x); h2[2] = bf_lo(c.y); h2[3] = bf_hi(c.y); h2[4] = bf_lo(c.z); h2[5] = bf_hi(c.z); h2[6] = bf_lo(c.w); h2[7] = bf_hi(c.w); }
#pragma unroll 4
            for (int rr = 0; rr < RUN; ++rr) {
                const u32x4 d = *(const u32x4*)(XB + (size_t)(r0 + rr) * D + ch0);
                const float h3[8] = {bf_lo(d.x), bf_hi(d.x), bf_lo(d.y), bf_hi(d.y), bf_lo(d.z), bf_hi(d.z), bf_lo(d.w), bf_hi(d.w)};
                float o[8];
#pragma unroll
                for (int i = 0; i < 8; ++i) { o[i] = bsv[i] + h0[i] * w[0][i] + h1[i] * w[1][i] + h2[i] * w[2][i] + h3[i] * w[3][i]; h0[i] = h1[i]; h1[i] = h2[i]; h2[i] = h3[i]; }
                u32x4 wv; wv.x = cvt_pk_bf16(o[0], o[1]); wv.y = cvt_pk_bf16(o[2], o[3]); wv.z = cvt_pk_bf16(o[4], o[5]); wv.w = cvt_pk_bf16(o[6], o[7]);
                *(u32x4*)(XN + (size_t)(r0 + rr) * D + ch0) = wv;
            }
        }
    }
    SEAM(5);
    if (IN(6)) { pg8::Gemm g{XN, Wgate, M, 2048, 128, D, 128}; pg8::StaticOrder S; S.init(M, 2048, G, (int)blockIdx.x);
        pg8::EpiLru E{XN, LA, args.in[I_BRG], args.in[I_BIG], NLA}; pg8::gemm_phase(ldsl, g, S, E); }
    SEAM(6);
    if (IN(7)) {
        for (int item = blockIdx.x; item < NB * NCHUNK; item += G) {
            const size_t r0 = (size_t)item * CHUNK; const int ch = tid * 2;
            float sl0 = 0.f, sl1 = 0.f, h0 = 0.f, h1 = 0.f;
#pragma unroll 8
            for (int i = 0; i < CHUNK; ++i) { const unsigned lw = *(const unsigned*)(LA + (r0 + i) * D + ch), gwv = *(const unsigned*)(XN + (r0 + i) * D + ch);
                const float l0 = bf_lo(lw), l1 = bf_hi(lw); sl0 += l0; sl1 += l1;
                h0 = __builtin_amdgcn_exp2f(l0 * 1.4426950408889634f) * h0 + bf_lo(gwv); h1 = __builtin_amdgcn_exp2f(l1 * 1.4426950408889634f) * h1 + bf_hi(gwv); }
            *(f32x4*)(PS + ((size_t)item * D + ch) * 2) = (f32x4){sl0, h0, sl1, h1};
        }
    }
    SEAM(7);
    if (IN(8)) {
        for (int item = blockIdx.x; item < NB * NCHUNK; item += G) {
            const int b = item / NCHUNK, c = item - b * NCHUNK; const size_t r0 = (size_t)item * CHUNK; const int ch = tid * 2;
            float h0 = 0.f, h1 = 0.f;
#pragma unroll 4
            for (int cc = 0; cc < c; ++cc) { const f32x4 p = *(const f32x4*)(PS + ((size_t)(b * NCHUNK + cc) * D + ch) * 2);
                h0 = __builtin_amdgcn_exp2f(p[0] * 1.4426950408889634f) * h0 + p[1]; h1 = __builtin_amdgcn_exp2f(p[2] * 1.4426950408889634f) * h1 + p[3]; }
#pragma unroll 8
            for (int i = 0; i < CHUNK; ++i) { const unsigned lw = *(const unsigned*)(LA + (r0 + i) * D + ch), gwv = *(const unsigned*)(XN + (r0 + i) * D + ch), yw = *(const unsigned*)(GY + (r0 + i) * D + ch);
                h0 = __builtin_amdgcn_exp2f(bf_lo(lw) * 1.4426950408889634f) * h0 + bf_lo(gwv); h1 = __builtin_amdgcn_exp2f(bf_hi(lw) * 1.4426950408889634f) * h1 + bf_hi(gwv);
                *(unsigned*)(XN + (r0 + i) * D + ch) = cvt_pk_bf16(h0 * bf_lo(yw), h1 * bf_hi(yw)); }
        }
    }
    SEAM(8);
    if (IN(9)) {
#ifndef P9SUB
#define P9SUB 7
#endif
        if (P9SUB & 1) { pg8::Gemm g{LAT, Wuq, M, 768, QLORA, LATP, 0}; pg8::StaticOrder S; S.init(M, 768, G, (int)blockIdx.x);
          pg8::EpiQ E{Qb, SSQ, CS}; pg8::gemm_phase(ldsl, g, S, E); }
        if (P9SUB & 2) { pg8::Gemm g{LAT + QLORA, Wukv, M, 1024, KVLORA, LATP, 0}; pg8::StaticOrder S; S.init(M, 1024, G, (int)blockIdx.x);
          pg8::EpiKV E{Kb, Vb, SSKV}; pg8::gemm_phase(ldsl, g, S, E); }
        if (P9SUB & 4) for (int i = blockIdx.x * 512 + tid; i < M * NHEAD; i += G * 512) { const int row = i >> 3, h = i & 7, b = row / SEQ, sp = row - b * SEQ;
            const u32x4* src = (const u32x4*)(LAT + (size_t)row * LATP + 640); const u32x4 a0 = src[0], a1 = src[1], b0 = src[2], b1 = src[3];
            const float x1[16] = {bf_lo(a0.x), bf_hi(a0.x), bf_lo(a0.y), bf_hi(a0.y), bf_lo(a0.z), bf_hi(a0.z), bf_lo(a0.w), bf_hi(a0.w), bf_lo(a1.x), bf_hi(a1.x), bf_lo(a1.y), bf_hi(a1.y), bf_lo(a1.z), bf_hi(a1.z), bf_lo(a1.w), bf_hi(a1.w)};
            const float x2[16] = {bf_lo(b0.x), bf_hi(b0.x), bf_lo(b0.y), bf_hi(b0.y), bf_lo(b0.z), bf_hi(b0.z), bf_lo(b0.w), bf_hi(b0.w), bf_lo(b1.x), bf_hi(b1.x), bf_lo(b1.y), bf_hi(b1.y), bf_lo(b1.z), bf_hi(b1.z), bf_lo(b1.w), bf_hi(b1.w)};
            const f32x4* cp = (const f32x4*)(CS + (size_t)row * 32); float o1[16], o2[16];
#pragma unroll
            for (int q = 0; q < 4; ++q) { const f32x4 cv = cp[q], sv = cp[4 + q];
#pragma unroll
                for (int e = 0; e < 4; ++e) { const int f = q * 4 + e; o1[f] = x1[f] * cv[e] - x2[f] * sv[e]; o2[f] = x2[f] * cv[e] + x1[f] * sv[e]; } }
            u32x4* dst = (u32x4*)(Kb + ((size_t)(b * NHEAD + h) * SEQ + sp) * DQK + 64);
            dst[0] = (u32x4){cvt_pk_bf16(o1[0], o1[1]), cvt_pk_bf16(o1[2], o1[3]), cvt_pk_bf16(o1[4], o1[5]), cvt_pk_bf16(o1[6], o1[7])};
            dst[1] = (u32x4){cvt_pk_bf16(o1[8], o1[9]), cvt_pk_bf16(o1[10], o1[11]), cvt_pk_bf16(o1[12], o1[13]), cvt_pk_bf16(o1[14], o1[15])};
            dst[2] = (u32x4){cvt_pk_bf16(o2[0], o2[1]), cvt_pk_bf16(o2[2], o2[3]), cvt_pk_bf16(o2[4], o2[5]), cvt_pk_bf16(o2[6], o2[7])};
            dst[3] = (u32x4){cvt_pk_bf16(o2[8], o2[9]), cvt_pk_bf16(o2[10], o2[11]), cvt_pk_bf16(o2[12], o2[13]), cvt_pk_bf16(o2[14], o2[15])}; }
    }
    SEAM(9);
    if (IN(10)) { att::attn_phase((char*)lds, (const att::bf16*)Qb, (const att::bf16*)Kb, (const att::bf16*)Vb, (att::bf16*)Ob); }
    SEAM(10);
    if (IN(11)) {
        { pg8::Gemm g{Ob, Wm, M, D, 512, 512, 0}; pg8::StaticOrder S; S.init(M, D, G, (int)blockIdx.x);
          pg8::EpiMerge<false> E{MG, SA}; pg8::gemm_phase(ldsl, g, S, E); }
        { pg8::Gemm g{XN, Wl, M, D, D, D, 0}; pg8::StaticOrder S; S.init(M, D, G, (int)blockIdx.x);
          pg8::EpiMerge<true> E{MG, SB}; pg8::gemm_phase(ldsl, g, S, E); }
    }
    SEAM(11);
    if (IN(12)) { pg8::Gemm g{MG, Wo, M, D, D, D, 0}; pg8::StaticOrder S; S.init(M, D, G, (int)blockIdx.x);
        pg8::EpiNormRes<false> E{nullptr, XN, SSZ, Y, args.in[I_MIXPOST], 1.0f, (float*)(ws + WS_XSLOT) + (size_t)M * 4, (unsigned*)(ws + WS_XCNT) + 128 * 64, (LAS float*)(ldsl + RING_BYTES)}; pg8::gemm_phase(ldsl, g, S, E); }
    SEAM(13);
    if (IN(14)) { pg8::Gemm g{XN, Wgu2, M, 2 * DFF, D, D, 0}; pg8::StaticOrder S; S.init(M, 2 * DFF, G, (int)blockIdx.x);
        pg8::EpiSwiGLU E{ACT, DFF, SSZ, true};   pg8::gemm_phase(ldsl, g, S, E); }
    SEAM(14);
    if (IN(15)) { pg8::Gemm g{ACT, Wd2, M, D, DFF, DFF, 0}; pg8::StaticOrder S; S.init(M, D, G, (int)blockIdx.x);
        pg8::EpiNormRes<true> E{out, nullptr, nullptr, XN, args.in[I_F2POST], 0.5f, (float*)(ws + WS_XSLOT) + (size_t)M * 8, (unsigned*)(ws + WS_XCNT) + 2 * 128 * 64, (LAS float*)(ldsl + RING_BYTES)}; pg8::gemm_phase(ldsl, g, S, E); }
#undef IN
#undef SEAM
}

extern "C" void kernel_launch(void* const* d_in, const int* in_sizes, int n_in, void* d_out, int out_size, void* d_ws, size_t ws_size, hipStream_t stream) {
    static int grid = 0;
    if (grid == 0) {
        if (n_in != 29 || in_sizes[0] != M * D || out_size != M * D || ws_size < WS_END) { fprintf(stderr, "kernel_launch: unexpected shapes (n_in %d, in0 %d, out %d, ws %zu)\n", n_in, n_in > 0 ? in_sizes[0] : -1, out_size, ws_size); grid = -1; return; }
        int dev = 0, cus = 0, per_cu = 0;
        (void)hipGetDevice(&dev); (void)hipDeviceGetAttribute(&cus, hipDeviceAttributeMultiprocessorCount, dev);
        if (hipFuncSetAttribute((const void*)mega_fwd, hipFuncAttributeMaxDynamicSharedMemorySize, LDS_BYTES) != hipSuccess) { fprintf(stderr, "kernel_launch: hipFuncSetAttribute failed\n"); grid = -1; return; }
        (void)hipOccupancyMaxActiveBlocksPerMultiprocessor(&per_cu, (const void*)mega_fwd, 512, LDS_BYTES);
        (void)hipGetLastError();
        if (per_cu < 1) fprintf(stderr, "kernel_launch: occupancy query reports %d blocks per CU\n", per_cu);
        grid = cus > 0 ? cus : 256;
    }
    if (grid < 0) return;
    if (hipMemsetAsync((unsigned char*)d_ws + WS_BAR, 0, (WS_XCNT - WS_BAR) + 3 * 128 * 64 * 4, stream) != hipSuccess) { fprintf(stderr, "kernel_launch: hipMemsetAsync failed\n"); return; }
    Args a{};
    for (int i = 0; i < 29; ++i) a.in[i] = (const float*)d_in[i];
    a.out = (float*)d_out; a.ws = (unsigned char*)d_ws; a.ph_lo = 0; a.ph_hi = 17;
    void* kargs[] = {&a};
    hipError_t e = hipLaunchCooperativeKernel((const void*)mega_fwd, dim3(grid), dim3(512), kargs, LDS_BYTES, stream);
    if (e != hipSuccess) fprintf(stderr, "kernel_launch: cooperative launch failed: %s (grid %d)\n", hipGetErrorString(e), grid);
}
```

```cpp
#include <hip/hip_runtime.h>
#include <hip/hip_cooperative_groups.h>
#include <hip/hip_bf16.h>
#include <cstdio>
#include <cstdint>
namespace cg = cooperative_groups;

#define LAS __attribute__((address_space(3)))
#define GAS __attribute__((address_space(1)))
typedef unsigned short bf16_t;
typedef short bf16x8 __attribute__((ext_vector_type(8)));
typedef short s16x4 __attribute__((ext_vector_type(4)));
typedef float f32x4 __attribute__((ext_vector_type(4)));
typedef float f32x2 __attribute__((ext_vector_type(2)));
typedef float f32x16 __attribute__((ext_vector_type(16)));
typedef unsigned u32x4 __attribute__((ext_vector_type(4)));
typedef unsigned u32x2 __attribute__((ext_vector_type(2)));

constexpr int SEQ = 16384, NB = 2, M = NB * SEQ, D = 1024, DFF = 2816;
constexpr int NHEAD = 8, DQK = 96, DVH = 64, QLORA = 384, KVLORA = 256, ROPE = 32;
constexpr int NWIN = 4864;
constexpr int LATP = 768;
constexpr float EPS = 1e-6f;
constexpr float QSCALE = 0.10206207261596575f * 1.4426950408889634f;
constexpr int NCHUNK = 128, CHUNK = SEQ / NCHUNK;

constexpr size_t MiB = 1u << 20, KiB = 1u << 10;
constexpr size_t WS_SSY1 = 0, WS_SSQ = 128 * KiB, WS_SSKV = 256 * KiB, WS_SSZ = 384 * KiB, WS_SSY2 = 512 * KiB, WS_RS0 = 640 * KiB, WS_RS1 = 768 * KiB, WS_RS2 = 896 * KiB, WS_NLA = 1 * MiB;
constexpr size_t WS_BAR = 1 * MiB + 64 * KiB;
constexpr size_t WS_XCNT = 1 * MiB + 128 * KiB;
constexpr size_t WS_XSLOT = 492 * MiB;
constexpr size_t WS_CS = 2 * MiB;
constexpr size_t WS_PS = 6 * MiB;
constexpr size_t WS_WGU1 = 8 * MiB, WS_WD1 = 19 * MiB, WS_WGU2 = 25 * MiB, WS_WD2 = 36 * MiB, WS_WIN = 42 * MiB, WS_WUQ = 52 * MiB, WS_WUKV = 53 * MiB,
                 WS_WM = 54 * MiB, WS_WL = 55 * MiB, WS_WO = 57 * MiB, WS_WGATE = 59 * MiB;
constexpr size_t WS_Y = 60 * MiB;
constexpr size_t WS_XN = 124 * MiB;
constexpr size_t WS_ACT = 188 * MiB;
constexpr size_t WS_LAT = 188 * MiB;
constexpr size_t WS_XB = 236 * MiB;
constexpr size_t WS_GY = 300 * MiB, WS_SA = 364 * MiB, WS_SB = 428 * MiB;
constexpr size_t WS_LA = 236 * MiB;
constexpr size_t WS_Q = 236 * MiB, WS_K = 284 * MiB, WS_V = 332 * MiB;
constexpr size_t WS_O = 188 * MiB;
constexpr size_t WS_MG = 236 * MiB;
constexpr size_t WS_Z = 300 * MiB;
constexpr size_t WS_END = 494 * MiB;

__device__ __forceinline__ unsigned cvt_pk_bf16(float lo, float hi) { unsigned r; asm volatile("v_cvt_pk_bf16_f32 %0, %1, %2" : "=v"(r) : "v"(lo), "v"(hi)); return r; }
__device__ __forceinline__ float bf_lo(unsigned w) { return __uint_as_float(w << 16); }
__device__ __forceinline__ float bf_hi(unsigned w) { return __uint_as_float(w & 0xffff0000u); }
__device__ __forceinline__ float fsigmoid(float x) { return __builtin_amdgcn_rcpf(1.f + __builtin_amdgcn_exp2f(-1.4426950408889634f * x)); }
__device__ __forceinline__ float fsilu(float x) { return x * fsigmoid(x); }
__device__ __forceinline__ float fgelu(float x) { return x * fsigmoid(1.5957691216057308f * (x + 0.044715f * x * x * x)); }
__device__ __forceinline__ float wave_sum(float v) {
#pragma unroll
    for (int o = 1; o < 64; o <<= 1) v += __shfl_xor(v, o);
    return v;
}
__device__ __forceinline__ void atomic_addf(float* p, float v) { (void)__hip_atomic_fetch_add(p, v, __ATOMIC_RELAXED, __HIP_MEMORY_SCOPE_AGENT); }

namespace pg8 {
#define PG8_LAS __attribute__((address_space(3)))
constexpr int BM = 256, BK = 64, HALF = 128, HTB = HALF * BK * 2, STAGE_BYTES = 8 * HTB, NXCD = 8, WGM = 8;
__host__ __device__ __forceinline__ int lds_byte(int r, int c) { const int st = (r >> 4) * 2 + (c >> 5), rr = r & 15, cc = c & 31, ob = rr * 64 + cc * 2; return st * 1024 + (ob ^ (((ob >> 9) & 1) << 5)); }
__host__ __device__ __forceinline__ void stage_rc(int b, int& R, int& C) { const int st = b / 1024, sb = b % 1024, swz = sb ^ (((sb >> 9) & 1) << 5); R = (st >> 1) * 16 + swz / 64; C = (st & 1) * 32 + (swz % 64) / 2; }
__host__ __device__ __forceinline__ int perm32(int rho) { const int n = rho >> 4, i = rho & 15; return 8 * (i >> 2) + 4 * n + (i & 3); }

struct Unit { int pm, pn; };
struct Gemm { const bf16_t* A; const bf16_t* Bt; int M, N, K, lda, acol; };

struct StaticOrder {
    int nM, nN, nwg, G, c;
    __host__ __device__ void init(int M_, int N_, int G_, int c_) { nM = M_ / BM; nN = N_ / BM; nwg = nM * nN; G = G_; c = c_; }
    __host__ __device__ bool next(int i, Unit& u) const {
        const long L = (long)i * G + c; if (L >= nwg) return false;
        int wgid = (int)L; { const int q = nwg / NXCD, r = nwg % NXCD, xcd = wgid % NXCD, off = wgid / NXCD; wgid = (xcd < r ? xcd * (q + 1) : r * (q + 1) + (xcd - r) * q) + off; }
        const int nig = WGM * nN, gid = wgid / nig, fm = gid * WGM, gsz = (nM - fm) < WGM ? (nM - fm) : WGM;
        u.pm = fm + ((wgid % nig) % gsz); u.pn = (wgid % nig) / gsz; return true;
    }
};

template <class Epi>
__device__ __forceinline__ void gemm_phase(PG8_LAS unsigned char* lds, const Gemm g, const StaticOrder& S, const Epi& E) {
    const int tid = threadIdx.x, wid = __builtin_amdgcn_readfirstlane(tid >> 6), lane = tid & 63, wr = wid >> 2, wc = wid & 3, fr = lane & 15, fq = lane >> 4;
    int Kop = g.K; asm volatile("" : "+s"(Kop));
    const int K = Kop, nt = K / BK;
    unsigned voffA[2], voffB[2];
#pragma unroll
    for (int i = 0; i < 2; ++i) { int R, C; stage_rc(tid * 16 + i * 8192, R, C); const int Rb = Epi::PERM ? ((R & ~31) + perm32(R & 31)) : R;
        voffA[i] = (unsigned)(R * g.lda + C) * 2u; voffB[i] = (unsigned)(Rb * K + C) * 2u; }
    const size_t kstep = (size_t)(BK * 2);
    const size_t hstepA = (size_t)HALF * g.lda * 2, hstepB = (size_t)HALF * K * 2;
    const size_t tstepA = 2 * hstepA, tstepB = 2 * hstepB;
    const unsigned ldsw = (unsigned)wid * 1024u;
    const int aoff = lds_byte(wr * 64 + fr, fq * 8), boff = lds_byte(wc * 32 + fr, fq * 8);
#define PG8_SA(b, h) (((b) * 2 + (h)) * HTB)
#define PG8_SB(b, h) ((4 + (b) * 2 + (h)) * HTB)
#define PG8_STAGE(bufoff, gbase, voff) do { _Pragma("unroll") for (int _i = 0; _i < 2; ++_i) \
        __builtin_amdgcn_global_load_lds((const unsigned*)((const char*)(gbase) + (voff)[_i]), (PG8_LAS unsigned*)(lds + (bufoff) + ldsw + _i * 8192), 16, 0, 0); } while (0)
#define PG8_LDA(dst, b, h) do { _Pragma("unroll") for (int m = 0; m < 4; ++m) _Pragma("unroll") for (int k = 0; k < 2; ++k) dst[m][k] = *(const PG8_LAS bf16x8*)(lds + PG8_SA(b, h) + aoff + m * 2048 + k * 1024); } while (0)
#define PG8_LDB(dst, b, h) do { _Pragma("unroll") for (int n = 0; n < 2; ++n) _Pragma("unroll") for (int k = 0; k < 2; ++k) dst[n][k] = *(const PG8_LAS bf16x8*)(lds + PG8_SB(b, h) + boff + n * 2048 + k * 1024); } while (0)
#define PG8_MMA(ai, bj, At, Bt) do { __builtin_amdgcn_s_setprio(1); _Pragma("unroll") for (int m = 0; m < 4; ++m) _Pragma("unroll") for (int n = 0; n < 2; ++n) _Pragma("unroll") for (int k = 0; k < 2; ++k) \
        acc[ai][bj][m][n] = __builtin_amdgcn_mfma_f32_16x16x32_bf16(Bt[n][k], At[m][k], acc[ai][bj][m][n], 0, 0, 0); __builtin_amdgcn_s_setprio(0); } while (0)
#define PG8_WAIT_V(n) asm volatile("s_waitcnt vmcnt(" #n ")" ::: "memory")
#define PG8_WAIT_L(n) asm volatile("s_waitcnt lgkmcnt(" #n ")" ::: "memory")
#define PG8_BAR __builtin_amdgcn_s_barrier()
#define PG8_SCHED __builtin_amdgcn_sched_barrier(0)
    Unit cur, nxt; int ui = 0;
    if (!S.next(0, cur)) return;
    f32x4 acc[2][2][4][2];
#pragma unroll
    for (int a = 0; a < 2; ++a)
#pragma unroll
        for (int b = 0; b < 2; ++b)
#pragma unroll
            for (int m = 0; m < 4; ++m)
#pragma unroll
                for (int n = 0; n < 2; ++n) acc[a][b][m][n] = (f32x4){0.f, 0.f, 0.f, 0.f};
    bf16x8 At[4][2], B0[2][2], B1[2][2];
    const char* cA = (const char*)g.A + (size_t)cur.pm * tstepA + (size_t)cur.pn * g.acol * 2; const char* cB = (const char*)g.Bt + (size_t)cur.pn * tstepB;
    PG8_STAGE(PG8_SB(0, 0), cB, voffB); PG8_STAGE(PG8_SB(0, 1), cB + hstepB, voffB); PG8_STAGE(PG8_SA(0, 0), cA, voffA); PG8_STAGE(PG8_SA(0, 1), cA + hstepA, voffA);
    if (wr == 1) PG8_BAR;
    PG8_WAIT_V(2); PG8_BAR;
    PG8_STAGE(PG8_SB(1, 0), cB + kstep, voffB); PG8_STAGE(PG8_SA(1, 0), cA + kstep, voffA); PG8_STAGE(PG8_SB(1, 1), cB + hstepB + kstep, voffB);
    PG8_WAIT_V(6); PG8_BAR;
    for (;;) {
        const bool has_next = S.next(ui + 1, nxt);
        const char* nA = has_next ? (const char*)g.A + (size_t)nxt.pm * tstepA + (size_t)nxt.pn * g.acol * 2 : cA; const char* nB = has_next ? (const char*)g.Bt + (size_t)nxt.pn * tstepB : cB;
#pragma clang loop unroll(disable)
        for (int t = 0; t < nt; t += 2) {
            const bool last = (t == nt - 2);
            const char* a1 = cA + (size_t)(t + 1) * kstep;
            const char* a2 = last ? nA : cA + (size_t)(t + 2) * kstep; const char* b2 = last ? nB : cB + (size_t)(t + 2) * kstep;
            const char* a3 = a2 + kstep; const char* b3 = b2 + kstep;
            PG8_LDB(B0, 0, 0); PG8_LDB(B1, 0, 1); PG8_SCHED; PG8_LDA(At, 0, 0); PG8_STAGE(PG8_SA(1, 1), a1 + hstepA, voffA);
            PG8_WAIT_V(8); PG8_WAIT_L(0); PG8_BAR; PG8_MMA(0, 0, At, B0); PG8_MMA(0, 1, At, B1); PG8_BAR; PG8_SCHED;
            PG8_LDA(At, 0, 1); PG8_STAGE(PG8_SB(0, 0), b2, voffB); PG8_STAGE(PG8_SB(0, 1), b2 + hstepB, voffB); PG8_STAGE(PG8_SA(0, 0), a2, voffA);
            PG8_WAIT_V(8); PG8_WAIT_L(0); PG8_BAR; PG8_MMA(1, 0, At, B0); PG8_MMA(1, 1, At, B1); PG8_BAR; PG8_SCHED;
            PG8_LDB(B0, 1, 0); PG8_LDB(B1, 1, 1); PG8_SCHED; PG8_LDA(At, 1, 0); PG8_STAGE(PG8_SA(0, 1), a2 + hstepA, voffA);
            PG8_WAIT_V(8); PG8_WAIT_L(0); PG8_BAR; PG8_MMA(0, 0, At, B0); PG8_MMA(0, 1, At, B1); PG8_BAR; PG8_SCHED;
            PG8_LDA(At, 1, 1); PG8_STAGE(PG8_SB(1, 0), b3, voffB); PG8_STAGE(PG8_SB(1, 1), b3 + hstepB, voffB); PG8_STAGE(PG8_SA(1, 0), a3, voffA);
            PG8_WAIT_V(8); PG8_WAIT_L(0); PG8_BAR; PG8_MMA(1, 0, At, B0); PG8_MMA(1, 1, At, B1); PG8_BAR; PG8_SCHED;
        }
        if (wr == 0) PG8_BAR;
        { int frx = fr, fqx = fq; asm volatile("" : "+v"(frx), "+v"(fqx));
          E(acc, cur, wr, wc, frx, fqx); }
        if (!has_next) break;
#pragma unroll
        for (int a = 0; a < 2; ++a)
#pragma unroll
            for (int b = 0; b < 2; ++b)
#pragma unroll
                for (int m = 0; m < 4; ++m)
#pragma unroll
                    for (int n = 0; n < 2; ++n) acc[a][b][m][n] = (f32x4){0.f, 0.f, 0.f, 0.f};
        cur = nxt; cA = nA; cB = nB; ++ui;
        if (wr == 1) PG8_BAR;
    }
    PG8_WAIT_V(0);
    PG8_BAR;
#undef PG8_SA
#undef PG8_SB
#undef PG8_STAGE
#undef PG8_LDA
#undef PG8_LDB
#undef PG8_MMA
#undef PG8_WAIT_V
#undef PG8_WAIT_L
#undef PG8_BAR
#undef PG8_SCHED
}

typedef const f32x4 (&AccRef)[2][2][4][2];
#define EPI_FENCE() asm volatile("" ::: "memory")

struct EpiSwiGLU {
    static constexpr bool PERM = true;
    bf16_t* O; int ldc; const float* rs; bool from_ss;
    __device__ __forceinline__ void operator()(AccRef acc, const Unit& u, int wr, int wc, int fr, int fq) const {
        bf16_t* base = O + (size_t)u.pm * BM * ldc + u.pn * 128 + wc * 32; const float* rsb = rs + u.pm * BM; const int r0 = wr * 64 + fr;
        float sv[2][4];
#pragma unroll
        for (int ai = 0; ai < 2; ++ai)
#pragma unroll
            for (int m = 0; m < 4; ++m) { const float t = rsb[r0 + ai * HALF + m * 16]; sv[ai][m] = from_ss ? rsqrtf(t * (1.f / D) + EPS) : t; }
#pragma unroll
        for (int ai = 0; ai < 2; ++ai)
#pragma unroll
            for (int m = 0; m < 4; ++m) { const int rl = r0 + ai * HALF + m * 16; const float s = sv[ai][m]; const unsigned off = (unsigned)(rl * ldc + 8 * fq);
                const f32x4 g0 = acc[ai][0][m][0] * s, g1 = acc[ai][0][m][1] * s, u0 = acc[ai][1][m][0] * s, u1 = acc[ai][1][m][1] * s;
                u32x4 w; w.x = cvt_pk_bf16(fsilu(g0[0]) * u0[0], fsilu(g0[1]) * u0[1]); w.y = cvt_pk_bf16(fsilu(g0[2]) * u0[2], fsilu(g0[3]) * u0[3]);
                w.z = cvt_pk_bf16(fsilu(g1[0]) * u1[0], fsilu(g1[1]) * u1[1]); w.w = cvt_pk_bf16(fsilu(g1[2]) * u1[2], fsilu(g1[3]) * u1[3]);
                *(u32x4*)(base + off) = w;
                EPI_FENCE(); }
    }
};
struct EpiBfSS {
    static constexpr bool PERM = true;
    bf16_t* O; int ldc; float* ss;
    __device__ __forceinline__ void operator()(AccRef acc, const Unit& u, int wr, int wc, int fr, int fq) const {
        bf16_t* base = O + (size_t)u.pm * BM * ldc + u.pn * BM + wc * 32; float* ssb = ss + u.pm * BM; const int r0 = wr * 64 + fr;
#pragma unroll
        for (int ai = 0; ai < 2; ++ai)
#pragma unroll
            for (int m = 0; m < 4; ++m) { const int rl = r0 + ai * HALF + m * 16; const unsigned off = (unsigned)(rl * ldc + 8 * fq); float q = 0.f;
#pragma unroll
                for (int bj = 0; bj < 2; ++bj) { const f32x4 v0 = acc[ai][bj][m][0], v1 = acc[ai][bj][m][1];
                    q += (v0[0] * v0[0] + v0[1] * v0[1]) + (v0[2] * v0[2] + v0[3] * v0[3]) + (v1[0] * v1[0] + v1[1] * v1[1]) + (v1[2] * v1[2] + v1[3] * v1[3]);
                    u32x4 w; w.x = cvt_pk_bf16(v0[0], v0[1]); w.y = cvt_pk_bf16(v0[2], v0[3]); w.z = cvt_pk_bf16(v1[0], v1[1]); w.w = cvt_pk_bf16(v1[2], v1[3]);
                    *(u32x4*)(base + off + bj * HALF) = w; }
                q += __shfl_xor(q, 16); q += __shfl_xor(q, 32);
                if (fq == 0) atomic_addf(ssb + rl, q);
                EPI_FENCE(); }
    }
};
struct EpiWin {
    static constexpr bool PERM = true;
    bf16_t* LAT; bf16_t* XB4; const float* rs; float* ssq; float* sskv;
    __device__ __forceinline__ void operator()(AccRef acc, const Unit& u, int wr, int wc, int fr, int fq) const {
        const int pn = u.pn; const bool lat = pn < 3; const int seg = lat ? 0 : ((pn - 3) >> 2); const int ldc = lat ? LATP : D;
        bf16_t* base = lat ? (LAT + (size_t)u.pm * BM * LATP + pn * BM + wc * 32) : (XB4 + (size_t)seg * M * D + (size_t)u.pm * BM * D + ((pn - 3) & 3) * BM + wc * 32);
        const float* rsb = rs + u.pm * BM; float* ssqb = ssq + u.pm * BM; float* sskvb = sskv + u.pm * BM; const int r0 = wr * 64 + fr;
        float sv[2][4];
#pragma unroll
        for (int ai = 0; ai < 2; ++ai)
#pragma unroll
            for (int m = 0; m < 4; ++m) sv[ai][m] = rsb[r0 + ai * HALF + m * 16];
#pragma unroll
        for (int ai = 0; ai < 2; ++ai)
#pragma unroll
            for (int m = 0; m < 4; ++m) { const int rl = r0 + ai * HALF + m * 16; const float s = sv[ai][m]; const unsigned off = (unsigned)(rl * ldc + 8 * fq);
#pragma unroll
                for (int bj = 0; bj < 2; ++bj) { f32x4 v0 = acc[ai][bj][m][0] * s, v1 = acc[ai][bj][m][1] * s;
                    if (lat) { const int sid = pn * 2 + bj;
                        if (sid < 5) { float q = (v0[0] * v0[0] + v0[1] * v0[1]) + (v0[2] * v0[2] + v0[3] * v0[3]) + (v1[0] * v1[0] + v1[1] * v1[1]) + (v1[2] * v1[2] + v1[3] * v1[3]);
                            q += __shfl_xor(q, 16); q += __shfl_xor(q, 32);
                            if (fq == 0) atomic_addf((sid < 3 ? ssqb : sskvb) + rl, q); } }
                    else if (seg == 1) {
#pragma unroll
                        for (int i = 0; i < 4; ++i) { v0[i] = fgelu(v0[i]); v1[i] = fgelu(v1[i]); } }
                    else if (seg >= 2) {
#pragma unroll
                        for (int i = 0; i < 4; ++i) { v0[i] = fsigmoid(v0[i]); v1[i] = fsigmoid(v1[i]); } }
                    u32x4 w; w.x = cvt_pk_bf16(v0[0], v0[1]); w.y = cvt_pk_bf16(v0[2], v0[3]); w.z = cvt_pk_bf16(v1[0], v1[1]); w.w = cvt_pk_bf16(v1[2], v1[3]);
                    *(u32x4*)(base + off + bj * HALF) = w; }
                EPI_FENCE(); }
    }
};
__device__ __forceinline__ float one_minus_exp(float y) {
    const float p = -y * (1.f + y * 0.5f * (1.f + y * (1.f / 3.f) * (1.f + y * 0.25f * (1.f + y * 0.2f * (1.f + y * (1.f / 6.f))))));
    const float e = 1.f - __builtin_amdgcn_exp2f(y * 1.4426950408889634f);
    return y > -0.25f ? p : e;
}
struct EpiLru {
    static constexpr bool PERM = true;
    bf16_t* XG; bf16_t* LA; const float* b_rg; const float* b_ig; const float* nla;
    __device__ __forceinline__ void operator()(AccRef acc, const Unit& u, int wr, int wc, int fr, int fq) const {
        const int chu = u.pn * 128 + wc * 32; const size_t ub = (size_t)u.pm * BM * D + chu; bf16_t* xgb = XG + ub; bf16_t* lab = LA + ub; const int r0 = wr * 64 + fr;
        f32x4 br[2], bi[2], nl[2];
#pragma unroll
        for (int n = 0; n < 2; ++n) { br[n] = *(const f32x4*)(b_rg + chu + 8 * fq + 4 * n); bi[n] = *(const f32x4*)(b_ig + chu + 8 * fq + 4 * n); nl[n] = *(const f32x4*)(nla + chu + 8 * fq + 4 * n); }
        u32x4 xwv[2][4];
#pragma unroll
        for (int ai = 0; ai < 2; ++ai)
#pragma unroll
            for (int m = 0; m < 4; ++m) xwv[ai][m] = *(const u32x4*)(xgb + (unsigned)((r0 + ai * HALF + m * 16) * D + 8 * fq));
#pragma unroll
        for (int ai = 0; ai < 2; ++ai)
#pragma unroll
            for (int m = 0; m < 4; ++m) { const int rl = r0 + ai * HALF + m * 16; const unsigned off = (unsigned)(rl * D + 8 * fq);
                const u32x4 xw = xwv[ai][m]; const float xc[8] = {bf_lo(xw.x), bf_hi(xw.x), bf_lo(xw.y), bf_hi(xw.y), bf_lo(xw.z), bf_hi(xw.z), bf_lo(xw.w), bf_hi(xw.w)};
                float la[8], gx[8];
#pragma unroll
                for (int n = 0; n < 2; ++n) { const f32x4 rv = acc[ai][0][m][n] + br[n], iv = acc[ai][1][m][n] + bi[n];
#pragma unroll
                    for (int i = 0; i < 4; ++i) { const float r = fsigmoid(rv[i]), ig = fsigmoid(iv[i]); la[4 * n + i] = nl[n][i] * r;
                        const float mult = __builtin_sqrtf(fmaxf(one_minus_exp(2.f * la[4 * n + i]), 0.f)); gx[4 * n + i] = mult * (ig * xc[4 * n + i]); } }
                u32x4 wl, wg; wl.x = cvt_pk_bf16(la[0], la[1]); wl.y = cvt_pk_bf16(la[2], la[3]); wl.z = cvt_pk_bf16(la[4], la[5]); wl.w = cvt_pk_bf16(la[6], la[7]);
                wg.x = cvt_pk_bf16(gx[0], gx[1]); wg.y = cvt_pk_bf16(gx[2], gx[3]); wg.z = cvt_pk_bf16(gx[4], gx[5]); wg.w = cvt_pk_bf16(gx[6], gx[7]);
                *(u32x4*)(lab + off) = wl; *(u32x4*)(xgb + off) = wg;
                EPI_FENCE(); }
    }
};
struct EpiQ {
    static constexpr bool PERM = false;
    bf16_t* Q; const float* ssq; const float* cs;
    __device__ __forceinline__ void operator()(AccRef acc, const Unit& u, int wr, int wc, int fr, int fq) const {
        const int b = (u.pm * BM) / SEQ, sp0 = u.pm * BM - b * SEQ; const float* ssb = ssq + u.pm * BM; const float* csb = cs + (size_t)u.pm * BM * 32; const int r0 = wr * 64 + fr;
        bf16_t* hb[2]; bool rope[2];
#pragma unroll
        for (int bj = 0; bj < 2; ++bj) { const int g32 = u.pn * 8 + bj * 4 + wc, head = g32 / 3, part = g32 - head * 3; rope[bj] = part == 2;
            hb[bj] = Q + ((size_t)(b * NHEAD + head) * SEQ + sp0) * DQK + part * 32; }
        const bool anyrope = rope[0] || rope[1];
        float ssv[2][4];
#pragma unroll
        for (int ai = 0; ai < 2; ++ai)
#pragma unroll
            for (int m = 0; m < 4; ++m) ssv[ai][m] = ssb[r0 + ai * HALF + m * 16];
        f32x4 cvn = {}, svn = {};
        if (anyrope) { cvn = *(const f32x4*)(csb + r0 * 32 + 4 * fq); svn = *(const f32x4*)(csb + r0 * 32 + 16 + 4 * fq); }
#pragma unroll
        for (int ai = 0; ai < 2; ++ai)
#pragma unroll
            for (int m = 0; m < 4; ++m) { const int rl = r0 + ai * HALF + m * 16; const float s = rsqrtf(ssv[ai][m] * (1.f / QLORA) + EPS) * QSCALE;
                const unsigned off = (unsigned)(rl * DQK + 4 * fq);
                const f32x4 cv = cvn, sv = svn;
                if (anyrope && !(ai == 1 && m == 3)) { const int rn = r0 + (m == 3 ? HALF : ai * HALF + (m + 1) * 16);
                    cvn = *(const f32x4*)(csb + rn * 32 + 4 * fq); svn = *(const f32x4*)(csb + rn * 32 + 16 + 4 * fq); }
#pragma unroll
                for (int bj = 0; bj < 2; ++bj) { f32x4 v0 = acc[ai][bj][m][0] * s, v1 = acc[ai][bj][m][1] * s;
                    if (rope[bj]) { const f32x4 x1 = v0, x2 = v1; v0 = x1 * cv - x2 * sv; v1 = x2 * cv + x1 * sv; }
                    u32x2 w0, w1; w0.x = cvt_pk_bf16(v0[0], v0[1]); w0.y = cvt_pk_bf16(v0[2], v0[3]); w1.x = cvt_pk_bf16(v1[0], v1[1]); w1.y = cvt_pk_bf16(v1[2], v1[3]);
                    *(u32x2*)(hb[bj] + off) = w0; *(u32x2*)(hb[bj] + off + 16) = w1; }
                EPI_FENCE(); }
    }
};
struct EpiKV {
    static constexpr bool PERM = false;
    bf16_t* Kb; bf16_t* Vb; const float* sskv;
    __device__ __forceinline__ void operator()(AccRef acc, const Unit& u, int wr, int wc, int fr, int fq) const {
        const int b = (u.pm * BM) / SEQ, sp0 = u.pm * BM - b * SEQ; const float* ssb = sskv + u.pm * BM; const int r0 = wr * 64 + fr;
        const bool isk = wc < 2; const int pitch = isk ? DQK : DVH;
        bf16_t* hb[2];
#pragma unroll
        for (int bj = 0; bj < 2; ++bj) { const size_t tok = (size_t)(b * NHEAD + u.pn * 2 + bj) * SEQ + sp0; hb[bj] = isk ? (Kb + tok * DQK + wc * 32) : (Vb + tok * DVH + (wc - 2) * 32); }
        float ssv[2][4];
#pragma unroll
        for (int ai = 0; ai < 2; ++ai)
#pragma unroll
            for (int m = 0; m < 4; ++m) ssv[ai][m] = ssb[r0 + ai * HALF + m * 16];
#pragma unroll
        for (int ai = 0; ai < 2; ++ai)
#pragma unroll
            for (int m = 0; m < 4; ++m) { const int rl = r0 + ai * HALF + m * 16; const float s = rsqrtf(ssv[ai][m] * (1.f / KVLORA) + EPS); const unsigned off = (unsigned)(rl * pitch + 4 * fq);
#pragma unroll
                for (int bj = 0; bj < 2; ++bj) { const f32x4 v0 = acc[ai][bj][m][0] * s, v1 = acc[ai][bj][m][1] * s;
                    u32x2 w0, w1; w0.x = cvt_pk_bf16(v0[0], v0[1]); w0.y = cvt_pk_bf16(v0[2], v0[3]); w1.x = cvt_pk_bf16(v1[0], v1[1]); w1.y = cvt_pk_bf16(v1[2], v1[3]);
                    *(u32x2*)(hb[bj] + off) = w0; *(u32x2*)(hb[bj] + off + 16) = w1; }
                EPI_FENCE(); }
    }
};
template <bool SECOND> struct EpiMerge {
    static constexpr bool PERM = true;
    bf16_t* O; const bf16_t* Gt;
    __device__ __forceinline__ void operator()(AccRef acc, const Unit& u, int wr, int wc, int fr, int fq) const {
        const size_t ub = (size_t)u.pm * BM * D + u.pn * BM + wc * 32; bf16_t* ob = O + ub; const bf16_t* gb = Gt + ub; const int r0 = wr * 64 + fr;
        u32x4 gn[2], pn[2] = {};
        { const unsigned off = (unsigned)(r0 * D + 8 * fq);
#pragma unroll
          for (int bj = 0; bj < 2; ++bj) { gn[bj] = *(const u32x4*)(gb + off + bj * HALF); if (SECOND) pn[bj] = *(const u32x4*)(ob + off + bj * HALF); } }
#pragma unroll
        for (int ai = 0; ai < 2; ++ai)
#pragma unroll
            for (int m = 0; m < 4; ++m) { const int rl = r0 + ai * HALF + m * 16; const unsigned off = (unsigned)(rl * D + 8 * fq);
                u32x4 gw[2], pw[2];
#pragma unroll
                for (int bj = 0; bj < 2; ++bj) { gw[bj] = gn[bj]; pw[bj] = pn[bj]; }
                if (!(ai == 1 && m == 3)) { const int rn = r0 + (m == 3 ? HALF : ai * HALF + (m + 1) * 16); const unsigned offn = (unsigned)(rn * D + 8 * fq);
#pragma unroll
                    for (int bj = 0; bj < 2; ++bj) { gn[bj] = *(const u32x4*)(gb + offn + bj * HALF); if (SECOND) pn[bj] = *(const u32x4*)(ob + offn + bj * HALF); } }
#pragma unroll
                for (int bj = 0; bj < 2; ++bj) { const f32x4 a0 = acc[ai][bj][m][0], a1 = acc[ai][bj][m][1]; const u32x4 g = gw[bj];
                    float o[8] = {bf_lo(g.x) * a0[0], bf_hi(g.x) * a0[1], bf_lo(g.y) * a0[2], bf_hi(g.y) * a0[3], bf_lo(g.z) * a1[0], bf_hi(g.z) * a1[1], bf_lo(g.w) * a1[2], bf_hi(g.w) * a1[3]};
                    if (SECOND) { const u32x4 p = pw[bj];
                        o[0] += bf_lo(p.x); o[1] += bf_hi(p.x); o[2] += bf_lo(p.y); o[3] += bf_hi(p.y); o[4] += bf_lo(p.z); o[5] += bf_hi(p.z); o[6] += bf_lo(p.w); o[7] += bf_hi(p.w); }
                    u32x4 w; w.x = cvt_pk_bf16(o[0], o[1]); w.y = cvt_pk_bf16(o[2], o[3]); w.z = cvt_pk_bf16(o[4], o[5]); w.w = cvt_pk_bf16(o[6], o[7]);
                    *(u32x4*)(ob + off + bj * HALF) = w; }
                EPI_FENCE(); }
    }
};
template <bool FINAL> struct EpiNormRes {
    static constexpr bool PERM = true;
    float* out; bf16_t* dst; float* ssout; const bf16_t* H; const float* g; float w; float* slots; unsigned* cnt; LAS float* xl;
    __device__ __forceinline__ void operator()(AccRef acc, const Unit& u, int wr, int wc, int fr, int fq) const {
        const int tid = threadIdx.x, lane = tid & 63; const int r0 = wr * 64 + fr;
        LAS float* P = xl; LAS float* S = xl + 1024;
#pragma unroll
        for (int ai = 0; ai < 2; ++ai)
#pragma unroll
            for (int m = 0; m < 4; ++m) { float q = 0.f;
#pragma unroll
                for (int bj = 0; bj < 2; ++bj) { const f32x4 v0 = acc[ai][bj][m][0], v1 = acc[ai][bj][m][1];
                    q += (v0[0] * v0[0] + v0[1] * v0[1]) + (v0[2] * v0[2] + v0[3] * v0[3]) + (v1[0] * v1[0] + v1[1] * v1[1]) + (v1[2] * v1[2] + v1[3] * v1[3]); }
                q += __shfl_xor(q, 16); q += __shfl_xor(q, 32);
                if (fq == 0) P[(r0 + ai * HALF + m * 16) * 4 + wc] = q; }
        __syncthreads();
        unsigned* pc = cnt + 64 * u.pm;
        if (tid < 256) { const float t = (P[tid * 4 + 0] + P[tid * 4 + 1]) + (P[tid * 4 + 2] + P[tid * 4 + 3]);
            __hip_atomic_store(slots + ((size_t)(u.pm * BM + tid) * 4 + u.pn), t, __ATOMIC_RELAXED, __HIP_MEMORY_SCOPE_AGENT);
            asm volatile("s_waitcnt vmcnt(0)" ::: "memory");
            if (lane == 0) (void)__hip_atomic_fetch_add(pc, 1u, __ATOMIC_RELAXED, __HIP_MEMORY_SCOPE_AGENT); }
        if (tid < 64) { unsigned sp = 0;
            while (__hip_atomic_load(pc, __ATOMIC_RELAXED, __HIP_MEMORY_SCOPE_AGENT) < 16u) { __builtin_amdgcn_s_sleep(1); if (++sp > (1u << 22)) break; }
            __builtin_amdgcn_fence(__ATOMIC_ACQUIRE, "agent"); asm volatile("s_waitcnt vmcnt(0)" ::: "memory"); }
        __syncthreads();
        if (tid < 256) { const float* sl = slots + (size_t)(u.pm * BM + tid) * 4; float t = 0.f;
#pragma unroll
            for (int k = 0; k < 4; ++k) t += __hip_atomic_load(sl + k, __ATOMIC_RELAXED, __HIP_MEMORY_SCOPE_AGENT);
            S[tid] = w * rsqrtf(t * (1.f / D) + EPS); }
        __syncthreads();
        const size_t ub = (size_t)u.pm * BM * D + u.pn * BM + wc * 32; const bf16_t* hb = H + ub; float* ssb = ssout + u.pm * BM;
        f32x4 gv[2][2];
#pragma unroll
        for (int bj = 0; bj < 2; ++bj)
#pragma unroll
            for (int n = 0; n < 2; ++n) gv[bj][n] = *(const f32x4*)(g + u.pn * BM + wc * 32 + bj * HALF + 8 * fq + 4 * n);
        u32x4 hn[2];
        { const unsigned off = (unsigned)(r0 * D + 8 * fq);
#pragma unroll
          for (int bj = 0; bj < 2; ++bj) hn[bj] = *(const u32x4*)(hb + off + bj * HALF); }
#pragma unroll
        for (int ai = 0; ai < 2; ++ai)
#pragma unroll
            for (int m = 0; m < 4; ++m) { const int rl = r0 + ai * HALF + m * 16; const unsigned off = (unsigned)(rl * D + 8 * fq); const float s = S[rl];
                u32x4 hw[2]; float q = 0.f;
#pragma unroll
                for (int bj = 0; bj < 2; ++bj) hw[bj] = hn[bj];
                if (!(ai == 1 && m == 3)) { const int rn = r0 + (m == 3 ? HALF : ai * HALF + (m + 1) * 16); const unsigned offn = (unsigned)(rn * D + 8 * fq);
#pragma unroll
                    for (int bj = 0; bj < 2; ++bj) hn[bj] = *(const u32x4*)(hb + offn + bj * HALF); }
#pragma unroll
                for (int bj = 0; bj < 2; ++bj) { const u32x4 h = hw[bj]; const f32x4 a0 = acc[ai][bj][m][0] * s * gv[bj][0], a1 = acc[ai][bj][m][1] * s * gv[bj][1];
                    f32x4 o0, o1; o0[0] = bf_lo(h.x) + a0[0]; o0[1] = bf_hi(h.x) + a0[1]; o0[2] = bf_lo(h.y) + a0[2]; o0[3] = bf_hi(h.y) + a0[3];
                    o1[0] = bf_lo(h.z) + a1[0]; o1[1] = bf_hi(h.z) + a1[1]; o1[2] = bf_lo(h.w) + a1[2]; o1[3] = bf_hi(h.w) + a1[3];
                    if (FINAL) { *(f32x4*)(out + ub + off + bj * HALF) = o0; *(f32x4*)(out + ub + off + bj * HALF + 4) = o1; }
                    else { q += (o0[0] * o0[0] + o0[1] * o0[1]) + (o0[2] * o0[2] + o0[3] * o0[3]) + (o1[0] * o1[0] + o1[1] * o1[1]) + (o1[2] * o1[2] + o1[3] * o1[3]);
                        u32x4 wv; wv.x = cvt_pk_bf16(o0[0], o0[1]); wv.y = cvt_pk_bf16(o0[2], o0[3]); wv.z = cvt_pk_bf16(o1[0], o1[1]); wv.w = cvt_pk_bf16(o1[2], o1[3]);
                        *(u32x4*)(dst + ub + off + bj * HALF) = wv; } }
                if (!FINAL) { q += __shfl_xor(q, 16); q += __shfl_xor(q, 32); if (fq == 0) atomic_addf(ssb + rl, q); }
                EPI_FENCE(); }
    }
};
}

namespace att {
using bf16 = __hip_bfloat16;
constexpr float SCALE = 0.10206207261596575f;
constexpr float THR = 8.f;
constexpr int NW = 8, QBLK = 32, KVBLK = 64, QB = NW * QBLK, NQB = SEQ / QB, OP = NHEAD * DVH;
constexpr int SHM_V = KVBLK * 128 * 2, SHM_K = KVBLK * 128 * 2;
constexpr int LDS_BYTES = 3 * SHM_V + 3 * SHM_K + NW * 64 * 4;
#define KSWZ(row, colB) ((row) * 256 + ((colB) ^ (((row) & 7) << 4)))
#define SBAR() __builtin_amdgcn_sched_barrier(0)
__device__ __forceinline__ int v_st(int k, int c) { const int kk = (k & ~0xC) | ((k & 4) << 1) | ((k & 8) >> 1); return ((kk >> 3) * 4 + (c >> 5)) * 512 + ((kk & 7) * 32 + (c & 31)) * 2; }
__device__ __forceinline__ int v_rd_base(int lane) { return ((lane & 3) << 3) | (((lane >> 2) & 3) << 6) | (((lane >> 4) & 1) << 5) | (((lane >> 5) & 1) << 8); }
constexpr int v_rd_off(int d0, int ks, int half) { return d0 * 512 + ks * 4096 + half * 2048; }
__device__ __forceinline__ int crow(int r, int hi) { return (r & 3) + 8 * (r >> 2) + 4 * hi; }
__device__ __forceinline__ unsigned cvtpk(float lo, float hi) { unsigned r; asm volatile("v_cvt_pk_bf16_f32 %0, %1, %2" : "=v"(r) : "v"(lo), "v"(hi)); return r; }
__device__ __forceinline__ bf16x8 load8(const bf16* p) { return *reinterpret_cast<const bf16x8*>(p); }
__device__ __forceinline__ void mask_tile(f32x16& p0, f32x16& p1, int dq) {
    const float NEG = -__builtin_inff();
#pragma unroll
    for (int r = 0; r < 16; ++r) {
        const int c = (r & 3) + 8 * (r >> 2);
        if (dq - c < 0) p0[r] = NEG;
        if (dq - c - 32 < 0) p1[r] = NEG;
    }
}
constexpr float THR2 = THR * 1.4426950408889634f;
template <bool FIRST>
__device__ __forceinline__ void partialSM(f32x16& p0, f32x16& p1, float& m_ref, f32x16& negm, float& alpha) {
    float pmax = p0[0];
#pragma unroll
    for (int r = 1; r < 16; ++r) pmax = fmaxf(pmax, p0[r]);
#pragma unroll
    for (int r = 0; r < 16; ++r) pmax = fmaxf(pmax, p1[r]);
    { auto rr = __builtin_amdgcn_permlane32_swap(__float_as_uint(pmax), __float_as_uint(pmax), false, false);
      pmax = fmaxf(__uint_as_float(rr[0]), __uint_as_float(rr[1])); }
    alpha = 1.f;
    if (FIRST || !__builtin_expect(__all(pmax <= THR2), 1)) {
        const float dl = FIRST ? pmax : fmaxf(pmax, 0.f); m_ref += dl; alpha = __builtin_amdgcn_exp2f(-dl);
#pragma unroll
        for (int r = 0; r < 16; ++r) { p0[r] -= dl; p1[r] -= dl; }
#pragma unroll
        for (int r = 0; r < 16; ++r) negm[r] = -m_ref;
    }
#pragma unroll
    for (int r = 0; r < 16; ++r) p0[r] = __builtin_amdgcn_exp2f(p0[r]);
}
__device__ __forceinline__ void finishSM(f32x16& p0, f32x16& p1, float alpha, float& l_reg, bf16x8& pa0, bf16x8& pa1, bf16x8& pa2, bf16x8& pa3) {
#pragma unroll
    for (int r = 0; r < 16; ++r) p1[r] = __builtin_amdgcn_exp2f(p1[r]);
    float ps = 0;
#pragma unroll
    for (int r = 0; r < 16; ++r) ps += p0[r];
#pragma unroll
    for (int r = 0; r < 16; ++r) ps += p1[r];
    { auto rr = __builtin_amdgcn_permlane32_swap(__float_as_uint(ps), __float_as_uint(ps), false, false);
      ps = __uint_as_float(rr[0]) + __uint_as_float(rr[1]); }
    l_reg = l_reg * alpha + ps;
#define PK4(P, B_, OUT) do { unsigned a0 = cvtpk(P[B_+0], P[B_+1]), a1 = cvtpk(P[B_+2], P[B_+3]);                          \
        unsigned b0 = cvtpk(P[B_+4], P[B_+5]), b1 = cvtpk(P[B_+6], P[B_+7]);                                             \
        auto r0 = __builtin_amdgcn_permlane32_swap(a0, b0, false, false); auto r1 = __builtin_amdgcn_permlane32_swap(a1, b1, false, false); \
        u32x4 w = {r0[0], r1[0], r0[1], r1[1]}; OUT = *reinterpret_cast<bf16x8*>(&w); } while (0)
    PK4(p0, 0, pa0); PK4(p0, 8, pa1); PK4(p1, 0, pa2); PK4(p1, 8, pa3);
#undef PK4
}
__device__ __forceinline__ void qkt(f32x16& p0, f32x16& p1, const char* Kbuf, int r32, int hi, const bf16x8* qr, const f32x16& negm) {
    p0 = negm; p1 = negm;
    const char* kb[4];
#pragma unroll
    for (int dd = 0; dd < 4; ++dd) kb[dd] = Kbuf + KSWZ(r32, (dd * 16 + hi * 8) * 2);
#pragma unroll
    for (int d0 = 0; d0 < 6; ++d0) { const char* a = kb[d0 & 3] + (d0 >> 2) * 128;
        bf16x8 b0 = *reinterpret_cast<const bf16x8*>(a);
        bf16x8 b1 = *reinterpret_cast<const bf16x8*>(a + 32 * 256);
        p0 = __builtin_amdgcn_mfma_f32_32x32x16_bf16(b0, qr[d0], p0, 0, 0, 0);
        p1 = __builtin_amdgcn_mfma_f32_32x32x16_bf16(b1, qr[d0], p1, 0, 0, 0); }
}
__device__ __forceinline__ void pv_tile(f32x16* o, int vb, bf16x8 pa0, bf16x8 pa1, bf16x8 pa2, bf16x8 pa3) {
#define TRRD(dst, off) asm volatile("ds_read_b64_tr_b16 %0, %1 offset:%2" : "=&v"(dst) : "v"(vb), "i"(off) : "memory")
#define PV_D0(d0) do { s16x4 l0, l1, l2, l3, h0, h1, h2, h3; constexpr int b_ = v_rd_off(d0, 0, 0); \
        TRRD(l0, b_); TRRD(h0, b_ + 2048); TRRD(l1, b_ + 4096); TRRD(h1, b_ + 6144); TRRD(l2, b_ + 8192); TRRD(h2, b_ + 10240); TRRD(l3, b_ + 12288); TRRD(h3, b_ + 14336); \
        asm volatile("s_waitcnt lgkmcnt(0)" ::: "memory"); SBAR();   \
        o[d0] = __builtin_amdgcn_mfma_f32_32x32x16_bf16(pa0, (bf16x8){l0[0], l0[1], l0[2], l0[3], h0[0], h0[1], h0[2], h0[3]}, o[d0], 0, 0, 0);   \
        o[d0] = __builtin_amdgcn_mfma_f32_32x32x16_bf16(pa1, (bf16x8){l1[0], l1[1], l1[2], l1[3], h1[0], h1[1], h1[2], h1[3]}, o[d0], 0, 0, 0);   \
        o[d0] = __builtin_amdgcn_mfma_f32_32x32x16_bf16(pa2, (bf16x8){l2[0], l2[1], l2[2], l2[3], h2[0], h2[1], h2[2], h2[3]}, o[d0], 0, 0, 0);   \
        o[d0] = __builtin_amdgcn_mfma_f32_32x32x16_bf16(pa3, (bf16x8){l3[0], l3[1], l3[2], l3[3], h3[0], h3[1], h3[2], h3[3]}, o[d0], 0, 0, 0); } while (0)
    PV_D0(0); PV_D0(1);
#undef PV_D0
#undef TRRD
}
struct BlockRef { const bf16* Q; const bf16* K; const bf16* V; bf16* O; int P0; };
struct Seam { bf16x8 qr[6]; bf16x8 st_v0, st_k0, st_k1; int rot; };
#define VMW() asm volatile("s_waitcnt vmcnt(0)" ::: "memory")
#define SLOAD_H(Kp, Vp, k0) do { S.st_v0 = load8((Vp) + (size_t)((k0) + vk) * DVH + vc); \
        if (kact) { S.st_k0 = load8((Kp) + (size_t)((k0) + sr) * DQK + sc); S.st_k1 = load8((Kp) + (size_t)((k0) + 32 + sr) * DQK + sc); } } while (0)
#define SWRITE_H(bf) do { *(bf16x8*)(V_lds + (bf) * SHM_V + vst0) = S.st_v0; \
        if (kact) { *(bf16x8*)(K_lds + (bf) * SHM_K + kws) = S.st_k0; *(bf16x8*)(K_lds + (bf) * SHM_K + kws + 32 * 256) = S.st_k1; } } while (0)
__device__ __forceinline__ void prime(const BlockRef& cur, char* lds, Seam& S) {
    const int tid = threadIdx.x, wid = __builtin_amdgcn_readfirstlane(tid >> 6), lane = tid & 63, r32 = lane & 31, hi = lane >> 5;
    const int sr = tid >> 4, sc = (tid & 15) * 8, kws = KSWZ(sr, sc * 2); const bool kact = sc < DQK; const int vk = tid >> 3, vc = (tid & 7) * 8, vst0 = v_st(vk, vc);
    char* V_lds = lds; char* K_lds = lds + 3 * SHM_V;
#pragma unroll
    for (int d0 = 0; d0 < 6; ++d0) S.qr[d0] = load8(cur.Q + (size_t)(wid * QBLK + r32) * DQK + d0 * 16 + hi * 8);
    SLOAD_H(cur.K, cur.V, 0); VMW(); SWRITE_H(0); SBAR();
    SLOAD_H(cur.K, cur.V, KVBLK);
    S.rot = 0;
    __syncthreads();
}
__device__ __forceinline__ void block(const BlockRef& cur, const BlockRef& nxt, char* lds, Seam& S) {
    const int tid = threadIdx.x, wid = __builtin_amdgcn_readfirstlane(tid >> 6), lane = tid & 63, r32 = lane & 31, hi = lane >> 5;
    const int NT = (cur.P0 + QB) / KVBLK;
    const int qlo = cur.P0 + wid * QBLK, qm = qlo + r32 - 4 * hi;
    char* V_lds = lds; char* K_lds = lds + 3 * SHM_V;
    float* ws = (float*)(lds + 3 * SHM_V + 3 * SHM_K) + wid * 64; float* li_l = ws, * al_l = ws + 32;
    float m_reg = 0.f, l_reg = 0; f32x16 o[2] = {}; f32x16 negm = {};
    const int sr = tid >> 4, sc = (tid & 15) * 8, kws = KSWZ(sr, sc * 2); const bool kact = sc < DQK;
    const int vk = tid >> 3, vc = (tid & 7) * 8, vst0 = v_st(vk, vc);
    const int vb0 = (int)(uintptr_t)V_lds + v_rd_base(lane);
    const bf16* Kh = cur.K; const bf16* Vh = cur.V;
    int rot = S.rot;
#define RESC(a) do { if (__any((a) < 1.f)) { if (hi == 0) al_l[r32] = (a); asm volatile("s_waitcnt lgkmcnt(0)" ::: "memory");              \
                     for (int d_ = 0; d_ < 2; ++d_) for (int r = 0; r < 16; ++r) o[d_][r] *= al_l[crow(r, hi)]; } } while (0)
#define MASKT(P0_, P1_, t) do { const int kb_ = (t) * KVBLK; if (kb_ + KVBLK - 1 > qlo) mask_tile(P0_, P1_, qm - kb_); } while (0)
    f32x16 pA0, pA1, pB0, pB1; float alA, alB; bf16x8 pa0, pa1, pa2, pa3;
#define STEP(PX0, PX1, mnX, alX, PY0, PY1, alY, t, HAS_PREV) do {                                                             \
        const int bn_ = rot == 2 ? 0 : rot + 1, bp_ = rot == 0 ? 2 : rot - 1;                                                 \
        VMW(); SWRITE_H(bn_); SBAR();                                                                                          \
        { const int tt_ = (t) + 2; const bool in_ = tt_ < NT; const bf16* Kp_ = in_ ? Kh : nxt.K; const bf16* Vp_ = in_ ? Vh : nxt.V; \
          const int k0_ = (in_ ? tt_ : tt_ - NT) * KVBLK; SLOAD_H(Kp_, Vp_, k0_); } SBAR();                                    \
        qkt(PX0, PX1, K_lds + rot * SHM_K, r32, hi, S.qr, negm);                                                               \
        if (HAS_PREV) { finishSM(PY0, PY1, alY, l_reg, pa0, pa1, pa2, pa3); SBAR();                                           \
                        pv_tile(o, vb0 + bp_ * SHM_V, pa0, pa1, pa2, pa3); }                                                   \
        MASKT(PX0, PX1, (t)); partialSM<!(HAS_PREV)>(PX0, PX1, m_reg, negm, alX);                                              \
        RESC(alX); __syncthreads(); rot = bn_; } while (0)
    STEP(pA0, pA1, mnA, alA, pB0, pB1, alB, 0, false);
    STEP(pB0, pB1, mnB, alB, pA0, pA1, alA, 1, true);
    for (int t = 2; t < NT; t += 2) {
        STEP(pA0, pA1, mnA, alA, pB0, pB1, alB, t, true);
        STEP(pB0, pB1, mnB, alB, pA0, pA1, alA, t + 1, true);
    }
#pragma unroll
    for (int d0 = 0; d0 < 6; ++d0) S.qr[d0] = load8(nxt.Q + (size_t)(wid * QBLK + r32) * DQK + d0 * 16 + hi * 8);
    SBAR();
    finishSM(pB0, pB1, alB, l_reg, pa0, pa1, pa2, pa3); SBAR();
    pv_tile(o, vb0 + (rot == 0 ? 2 : rot - 1) * SHM_V, pa0, pa1, pa2, pa3);
    S.rot = rot;
    if (hi == 0) li_l[r32] = l_reg; asm volatile("s_waitcnt lgkmcnt(0)" ::: "memory");
    float rli[16];
#pragma unroll
    for (int r = 0; r < 16; ++r) rli[r] = __builtin_amdgcn_rcpf(li_l[crow(r, hi)]);
    bf16* Ow = cur.O + (size_t)(wid * QBLK) * OP;
#pragma unroll
    for (int r = 0; r < 16; ++r) { const int orow = crow(r, hi);
#pragma unroll
        for (int d0 = 0; d0 < 2; ++d0) { const float v = o[d0][r] * rli[r];
            const float vn = __shfl_xor(v, 1);
            if ((r32 & 1) == 0) *(unsigned*)(Ow + (size_t)orow * OP + d0 * 32 + r32) = cvtpk(v, vn); } }
#undef RESC
#undef MASKT
#undef STEP
}
#undef VMW
#undef SLOAD_H
#undef SWRITE_H
__device__ __forceinline__ BlockRef mkref(int idx, const bf16* Q, const bf16* K, const bf16* V, bf16* O) {
    const int item = idx >> 1, pass = idx & 1, bh = item >> 5, x = item & 31, qb = pass ? (NQB - 1 - x) : x, b = bh >> 3, h = bh & 7;
    BlockRef r;
    r.Q = Q + ((size_t)bh * SEQ + (size_t)qb * QB) * DQK; r.K = K + (size_t)bh * SEQ * DQK; r.V = V + (size_t)bh * SEQ * DVH;
    r.O = O + ((size_t)b * SEQ + (size_t)qb * QB) * OP + h * DVH; r.P0 = qb * QB;
    return r;
}
__device__ __forceinline__ void attn_phase(char* lds, const bf16* Q, const bf16* K, const bf16* V, bf16* O) {
    constexpr int NITEMS = NB * NHEAD * (NQB / 2);
    const int G = gridDim.x;
    int it = (G % 8 == 0) ? (int)((blockIdx.x & 7) * (G / 8) + (blockIdx.x >> 3)) : (int)blockIdx.x;
    if (it < NITEMS) {
        int idx = it * 2;
        BlockRef cur = mkref(idx, Q, K, V, O);
        Seam S;
        prime(cur, lds, S);
        for (;;) {
            int nidx;
            if ((idx & 1) == 0) nidx = idx + 1; else { const int nit = (idx >> 1) + G; nidx = nit < NITEMS ? nit * 2 : -1; }
            const bool last = nidx < 0;
            const BlockRef nxt = last ? cur : mkref(nidx, Q, K, V, O);
            block(cur, nxt, lds, S);
            if (last) break;
            cur = nxt; idx = nidx;
        }
    }
}
#undef KSWZ
#undef SBAR
}

#define XB_TMO      128
#define XB_XCNT(j)  (256  + 64 * (j))
#define XB_XSUB(j)  (1280 + 64 * (j))
#define XB_XGEN(j)  (2304 + 64 * (j))
#define XB_TOP      3328
#define XB_TOPGEN   3392
#define XCD_BAR_WORDS 3456
#define XB_SPIN_CAP (1u << 18)

__device__ __forceinline__ unsigned xb_ld(unsigned* p)              { return __hip_atomic_load(p, __ATOMIC_RELAXED, __HIP_MEMORY_SCOPE_AGENT); }
__device__ __forceinline__ unsigned xb_add(unsigned* p, unsigned v) { return __hip_atomic_fetch_add(p, v, __ATOMIC_RELAXED, __HIP_MEMORY_SCOPE_AGENT); }
__device__ __forceinline__ unsigned xb_xcc_id() { return (unsigned)__builtin_amdgcn_s_getreg((3 << 11) | 20) & 0xFu; }
#define XB_SPIN(cond, bar) do { unsigned _sp = 0; while (cond) { __builtin_amdgcn_s_sleep(1); \
    if ((++_sp & 255u) == 0u) { if (xb_ld(&(bar)[XB_TMO])) break; if (_sp > XB_SPIN_CAP) { atomicAdd(&(bar)[XB_TMO], 1u); break; } } } } while (0)

struct XcdBarrier {
    unsigned* bar; unsigned x;
    volatile LAS unsigned* st;
};

__device__ __forceinline__ XcdBarrier xcd_barrier_post(unsigned* bar, volatile LAS unsigned* st) {
    XcdBarrier b; b.bar = bar; b.x = xb_xcc_id(); b.st = st;
    if (threadIdx.x == 0) (void)xb_add(&bar[XB_XCNT(b.x)], 1u);
    return b;
}
__device__ __forceinline__ void xcd_barrier_complete(unsigned* bar, unsigned x, unsigned& nloc, unsigned& nx) {
    const unsigned G = gridDim.x * gridDim.y * gridDim.z;
    unsigned sum, cnt, mine, sp = 0u;
    for (;;) {
        sum = 0u; cnt = 0u; mine = 0u;
#pragma unroll
        for (unsigned j = 0; j < 16; ++j) { const unsigned c = xb_ld(&bar[XB_XCNT(j)]); sum += c; cnt += (c > 0u) ? 1u : 0u; mine = (j == x) ? c : mine; }
        if (sum == G) break;
        __builtin_amdgcn_s_sleep(1);
        if ((++sp & 255u) == 0u) { if (xb_ld(&bar[XB_TMO])) break; if (sp > XB_SPIN_CAP) { atomicAdd(&bar[XB_TMO], 1u); break; } }
    }
    nloc = mine > 0u ? mine : 1u; nx = cnt > 0u ? cnt : 1u;
}

__device__ __forceinline__ void xcd_barrier(const XcdBarrier& b) {
    asm volatile("s_waitcnt vmcnt(0)" ::: "memory");
    __syncthreads();
    if (threadIdx.x == 0) {
        unsigned* bar = b.bar;
        __builtin_amdgcn_s_waitcnt(0);
        unsigned nloc = b.st[0], nx = b.st[1];
        if (nloc == 0u) { xcd_barrier_complete(bar, b.x, nloc, nx); b.st[0] = nloc; b.st[1] = nx; }
        const unsigned old = xb_add(&bar[XB_XSUB(b.x)], 1u);
        const unsigned gen = old / nloc;
        if (old + 1u == (gen + 1u) * nloc) {
            __builtin_amdgcn_fence(__ATOMIC_RELEASE, "agent");
            asm volatile("s_waitcnt vmcnt(0)" ::: "memory");
            const unsigned og = xb_add(&bar[XB_TOP], 1u);
            const unsigned tg = og / nx;
            if (og + 1u == (tg + 1u) * nx) xb_add(&bar[XB_TOPGEN], 1u);
            else XB_SPIN(xb_ld(&bar[XB_TOPGEN]) == tg, bar);
            __builtin_amdgcn_fence(__ATOMIC_ACQUIRE, "agent");
            xb_add(&bar[XB_XGEN(b.x)], 1u);
            asm volatile("s_waitcnt vmcnt(0)" ::: "memory");
        } else {
            XB_SPIN(xb_ld(&bar[XB_XGEN(b.x)]) == gen, bar);
            __builtin_amdgcn_fence(__ATOMIC_ACQUIRE, "agent");
            asm volatile("s_waitcnt vmcnt(0)" ::: "memory");
        }
    }
    __syncthreads();
}


constexpr int RING_BYTES = 131072, LDS_BYTES = 147456;
static_assert(att::LDS_BYTES <= RING_BYTES, "attention scratch fits the ring region");

static __device__ const double kInvFreq[16] = {1.0, 0.5623413251903491, 0.31622776601683794, 0.1778279410038923, 0.1, 0.05623413251903491, 0.03162277660168379, 0.01778279410038923, 0.01, 0.005623413251903491, 0.0031622776601683794, 0.0017782794100389228, 0.001, 0.0005623413251903491, 0.00031622776601683794, 0.00017782794100389227};
struct Args { const float* in[29]; float* out; unsigned char* ws; int ph_lo, ph_hi; };
enum { I_X = 0, I_POS, I_F1PRE, I_F1G, I_F1U, I_F1D, I_F1POST, I_MIXPRE, I_WIN, I_QNG, I_WUQ, I_KVNG, I_WUKV, I_WOMLA, I_CONVW, I_CONVB, I_WRG, I_BRG, I_WIG, I_BIG, I_LAMBDA, I_WOLRU, I_WOUT, I_MIXPOST,
       I_F2PRE, I_F2G, I_F2U, I_F2D, I_F2POST };

__device__ __forceinline__ unsigned f2bf(float f) { unsigned u = __builtin_bit_cast(unsigned, f); return (u + 0x7fffu + ((u >> 16) & 1u)) >> 16; }
__device__ __forceinline__ unsigned pk2(float lo, float hi) { return f2bf(lo) | (f2bf(hi) << 16); }
#define LDS_WAIT() asm volatile("s_waitcnt lgkmcnt(0)" ::: "memory")

__device__ __forceinline__ void tr_item(const float* W, int ld, int c0, int K, int ncols, bf16_t* WT, int row_off, int il, const float* gv, LAS float* scr, int item, int lane) {
    const int nblk = ncols / 32, kb = item / nblk, nb = item % nblk, k0 = 64 * kb, n0 = 32 * nb;
#pragma unroll
    for (int i = 0; i < 32; ++i) { const int kk = 2 * i + (lane >> 5); float v = W[(size_t)(k0 + kk) * ld + c0 + n0 + (lane & 31)]; if (gv) v *= gv[k0 + kk]; scr[kk * 33 + (lane & 31)] = v; }
    LDS_WAIT(); asm volatile("" ::: "memory");
    const int c = lane & 7;
#pragma unroll
    for (int j = 0; j < 4; ++j) { const int n = (lane >> 3) + 8 * j, nn = n0 + n; const int drow = row_off + (il < 0 ? nn : ((nn >> 7) * 256 + (nn & 127) + 128 * il));
        const LAS float* s = scr + (8 * c) * 33 + n;
        u32x4 o; o.x = pk2(s[0 * 33], s[1 * 33]); o.y = pk2(s[2 * 33], s[3 * 33]); o.z = pk2(s[4 * 33], s[5 * 33]); o.w = pk2(s[6 * 33], s[7 * 33]);
        *(u32x4*)(WT + (size_t)drow * K + k0 + 8 * c) = o; }
    LDS_WAIT(); asm volatile("" ::: "memory");
}

__global__ void __launch_bounds__(512, 2) mega_fwd(Args args) {
    extern __shared__ __attribute__((aligned(16))) unsigned char lds[];
    cg::grid_group grid = cg::this_grid();
    const int tid = threadIdx.x, lane = tid & 63, wave = __builtin_amdgcn_readfirstlane(tid >> 6);
    const int G = gridDim.x, gw = blockIdx.x * 8 + wave, NGW = G * 8;
    unsigned char* ws = args.ws;
    LAS unsigned char* ldsl = (LAS unsigned char*)lds;
    const float* x = args.in[I_X]; float* out = args.out;
    float* SSY1 = (float*)(ws + WS_SSY1); float* SSQ = (float*)(ws + WS_SSQ); float* SSKV = (float*)(ws + WS_SSKV); float* SSZ = (float*)(ws + WS_SSZ); float* SSY2 = (float*)(ws + WS_SSY2);
    float* RS0 = (float*)(ws + WS_RS0); float* RS1 = (float*)(ws + WS_RS1); float* RS2 = (float*)(ws + WS_RS2); float* NLA = (float*)(ws + WS_NLA);
    float* CS = (float*)(ws + WS_CS); float* PS = (float*)(ws + WS_PS);
    bf16_t* Wgu1 = (bf16_t*)(ws + WS_WGU1); bf16_t* Wd1 = (bf16_t*)(ws + WS_WD1); bf16_t* Wgu2 = (bf16_t*)(ws + WS_WGU2); bf16_t* Wd2 = (bf16_t*)(ws + WS_WD2);
    bf16_t* Win = (bf16_t*)(ws + WS_WIN); bf16_t* Wuq = (bf16_t*)(ws + WS_WUQ); bf16_t* Wukv = (bf16_t*)(ws + WS_WUKV); bf16_t* Wm = (bf16_t*)(ws + WS_WM); bf16_t* Wl = (bf16_t*)(ws + WS_WL);
    bf16_t* Wo = (bf16_t*)(ws + WS_WO); bf16_t* Wgate = (bf16_t*)(ws + WS_WGATE);
    bf16_t* Y = (bf16_t*)(ws + WS_Y); bf16_t* XN = (bf16_t*)(ws + WS_XN); bf16_t* ACT = (bf16_t*)(ws + WS_ACT); bf16_t* LAT = (bf16_t*)(ws + WS_LAT);
    bf16_t* XB = (bf16_t*)(ws + WS_XB); bf16_t* GY = (bf16_t*)(ws + WS_GY); bf16_t* SA = (bf16_t*)(ws + WS_SA); bf16_t* SB = (bf16_t*)(ws + WS_SB); bf16_t* LA = (bf16_t*)(ws + WS_LA);
    bf16_t* Qb = (bf16_t*)(ws + WS_Q); bf16_t* Kb = (bf16_t*)(ws + WS_K); bf16_t* Vb = (bf16_t*)(ws + WS_V); bf16_t* Ob = (bf16_t*)(ws + WS_O); bf16_t* MG = (bf16_t*)(ws + WS_MG); bf16_t* Zb = (bf16_t*)(ws + WS_Z);
    const int lo = args.ph_lo, hi = args.ph_hi;
#ifndef PHMASK
#define PHMASK 0x1FFFF
#endif
#define IN(k) (((PHMASK >> (k)) & 1) && lo <= (k) && (k) < hi)
    volatile LAS unsigned* bst = (volatile LAS unsigned*)(ldsl + RING_BYTES + 64);
    if (tid == 0) { bst[0] = 0u; bst[1] = 0u; }
    __syncthreads();
    XcdBarrier xbar; xbar.bar = (unsigned*)(ws + WS_BAR); xbar.x = 0; xbar.st = bst;
#define SEAM(k) do { if (IN(k) && IN((k) + 1)) { if ((k) == 0) { grid.sync(); xbar = xcd_barrier_post((unsigned*)(ws + WS_BAR), bst); } else xcd_barrier(xbar); } } while (0)

    if (IN(0)) {
        LAS float* scr = (LAS float*)(ldsl + wave * 16384);
        constexpr int I_GU = (D / 64) * (DFF / 32), I_DN = (DFF / 64) * (D / 32), I_WIN0 = (D / 64) * (672 / 32), I_WIN1 = (D / 64) * (4096 / 32), I_UQ = (QLORA / 64) * (768 / 32),
                      I_UKV = (KVLORA / 64) * (1024 / 32), I_M = (512 / 64) * (D / 32), I_SQ = (D / 64) * (D / 32), I_GT = 8 * (128 / 64) * (128 / 32);
        constexpr int NITEMS = 4 * I_GU + 2 * I_DN + I_WIN0 + I_WIN1 + I_UQ + I_UKV + I_M + 2 * I_SQ + 2 * I_GT;
        for (int it = gw; it < NITEMS; it += NGW) {
            int r = it;
            if (r < I_GU) { tr_item(args.in[I_F1G], DFF, 0, D, DFF, Wgu1, 0, 0, args.in[I_F1PRE], scr, r, lane); continue; } r -= I_GU;
            if (r < I_GU) { tr_item(args.in[I_F1U], DFF, 0, D, DFF, Wgu1, 0, 1, args.in[I_F1PRE], scr, r, lane); continue; } r -= I_GU;
            if (r < I_DN) { tr_item(args.in[I_F1D], D, 0, DFF, D, Wd1, 0, -1, nullptr, scr, r, lane); continue; } r -= I_DN;
            if (r < I_GU) { tr_item(args.in[I_F2G], DFF, 0, D, DFF, Wgu2, 0, 0, args.in[I_F2PRE], scr, r, lane); continue; } r -= I_GU;
            if (r < I_GU) { tr_item(args.in[I_F2U], DFF, 0, D, DFF, Wgu2, 0, 1, args.in[I_F2PRE], scr, r, lane); continue; } r -= I_GU;
            if (r < I_DN) { tr_item(args.in[I_F2D], D, 0, DFF, D, Wd2, 0, -1, nullptr, scr, r, lane); continue; } r -= I_DN;
            if (r < I_WIN0) { tr_item(args.in[I_WIN], 4768, 0, D, 672, Win, 0, -1, args.in[I_MIXPRE], scr, r, lane); continue; } r -= I_WIN0;
            if (r < I_WIN1) { tr_item(args.in[I_WIN], 4768, 672, D, 4096, Win, 768, -1, args.in[I_MIXPRE], scr, r, lane); continue; } r -= I_WIN1;
            if (r < I_UQ) { tr_item(args.in[I_WUQ], 768, 0, QLORA, 768, Wuq, 0, -1, args.in[I_QNG], scr, r, lane); continue; } r -= I_UQ;
            if (r < I_UKV) { tr_item(args.in[I_WUKV], 1024, 0, KVLORA, 1024, Wukv, 0, -1, args.in[I_KVNG], scr, r, lane); continue; } r -= I_UKV;
            if (r < I_M) { tr_item(args.in[I_WOMLA], D, 0, 512, D, Wm, 0, -1, nullptr, scr, r, lane); continue; } r -= I_M;
            if (r < I_SQ) { tr_item(args.in[I_WOLRU], D, 0, D, D, Wl, 0, -1, nullptr, scr, r, lane); continue; } r -= I_SQ;
            if (r < I_SQ) { tr_item(args.in[I_WOUT], D, 0, D, D, Wo, 0, -1, nullptr, scr, r, lane); continue; } r -= I_SQ;
            if (r < I_GT) { const int g = r >> 3; tr_item(args.in[I_WRG] + (size_t)g * 16384, 128, 0, 128, 128, Wgate + (size_t)g * 32768, 0, 0, nullptr, scr, r & 7, lane); continue; } r -= I_GT;
            { const int g = r >> 3; tr_item(args.in[I_WIG] + (size_t)g * 16384, 128, 0, 128, 128, Wgate + (size_t)g * 32768, 0, 1, nullptr, scr, r & 7, lane); }
        }
        if (blockIdx.x == 0) { for (int i = tid; i < XCD_BAR_WORDS; i += 512) ((unsigned*)(ws + WS_BAR))[i] = 0u;
            for (int i = tid; i < 3 * 128 * 64; i += 512) ((unsigned*)(ws + WS_XCNT))[i] = 0u; }
        for (int i = blockIdx.x * 512 + tid; i < 96 * D / 8; i += G * 512) *(u32x4*)(Win + (size_t)672 * D + (size_t)i * 8) = (u32x4){0u, 0u, 0u, 0u};
        for (int m0 = gw; m0 < M; m0 += 2 * NGW) {
            const bool two = m0 + NGW < M; const int mm[2] = {m0, two ? m0 + NGW : m0}; f32x4 v[2][4]; float sv[2];
#pragma unroll
            for (int r = 0; r < 2; ++r)
#pragma unroll
                for (int j = 0; j < 4; ++j) v[r][j] = ((const f32x4*)(x + (size_t)mm[r] * D) + lane)[64 * j];
#pragma unroll
            for (int r = 0; r < 2; ++r) { float s = 0.f;
#pragma unroll
                for (int j = 0; j < 4; ++j) s += (v[r][j][0] * v[r][j][0] + v[r][j][1] * v[r][j][1]) + (v[r][j][2] * v[r][j][2] + v[r][j][3] * v[r][j][3]);
                sv[r] = wave_sum(s); }
#pragma unroll
            for (int r = 0; r < 2; ++r) if (r == 0 || two) { const int m = mm[r]; u32x2* o8 = (u32x2*)(XN + (size_t)m * D) + lane;
#pragma unroll
                for (int j = 0; j < 4; ++j) { u32x2 w; w.x = cvt_pk_bf16(v[r][j][0], v[r][j][1]); w.y = cvt_pk_bf16(v[r][j][2], v[r][j][3]); o8[64 * j] = w; }
                if (lane == 0) { RS0[m] = rsqrtf(sv[r] * (1.f / D) + EPS); SSY1[m] = 0.f; SSQ[m] = 0.f; SSKV[m] = 0.f; SSZ[m] = 0.f; SSY2[m] = 0.f; } }
        }
        { const int* pos = (const int*)args.in[I_POS];
          for (int i = blockIdx.x * 512 + tid; i < M * 16; i += G * 512) { const int row = i >> 4, f = i & 15;
              const double ang = (double)pos[row] * kInvFreq[f]; const double kq = rint(ang * 0.15915494309189535);
              const float rf = (float)fma(-kq, 6.283185307179586, ang); float sn, cn; sincosf(rf, &sn, &cn);
              CS[(size_t)row * 32 + f] = cn; CS[(size_t)row * 32 + 16 + f] = sn; } }
        for (int i = blockIdx.x * 512 + tid; i < D; i += G * 512) { const float l = args.in[I_LAMBDA][i]; NLA[i] = -8.f * log1pf(expf(-l)); }
    }
    SEAM(0);
    if (IN(1)) { pg8::Gemm g{XN, Wgu1, M, 2 * DFF, D, D, 0}; pg8::StaticOrder S; S.init(M, 2 * DFF, G, (int)blockIdx.x);
        pg8::EpiSwiGLU E{ACT, DFF, RS0, false}; pg8::gemm_phase(ldsl, g, S, E); }
    SEAM(1);
    if (IN(2)) { pg8::Gemm g{ACT, Wd1, M, D, DFF, DFF, 0}; pg8::StaticOrder S; S.init(M, D, G, (int)blockIdx.x);
        pg8::EpiBfSS E{Y, D, SSY1}; pg8::gemm_phase(ldsl, g, S, E); }
    SEAM(2);
    if (IN(3)) {
        f32x4 gv[4];
#pragma unroll
        for (int j = 0; j < 4; ++j) gv[j] = ((const f32x4*)args.in[I_F1POST])[lane + 64 * j];
        for (int m0 = gw; m0 < M; m0 += 2 * NGW) {
            const bool two = m0 + NGW < M; const int mm[2] = {m0, two ? m0 + NGW : m0}; u32x2 xw[2][4], yw[2][4]; f32x4 v[2][4]; float rsy[2], sv[2];
#pragma unroll
            for (int r = 0; r < 2; ++r) { rsy[r] = SSY1[mm[r]];
#pragma unroll
                for (int j = 0; j < 4; ++j) { xw[r][j] = ((const u32x2*)(XN + (size_t)mm[r] * D) + lane)[64 * j]; yw[r][j] = ((const u32x2*)(Y + (size_t)mm[r] * D) + lane)[64 * j]; } }
#pragma unroll
            for (int r = 0; r < 2; ++r) { const float ry = 0.5f * rsqrtf(rsy[r] * (1.f / D) + EPS); float s = 0.f;
#pragma unroll
                for (int j = 0; j < 4; ++j) { f32x4& h = v[r][j]; h[0] = bf_lo(xw[r][j].x) + bf_lo(yw[r][j].x) * ry * gv[j][0]; h[1] = bf_hi(xw[r][j].x) + bf_hi(yw[r][j].x) * ry * gv[j][1];
                    h[2] = bf_lo(xw[r][j].y) + bf_lo(yw[r][j].y) * ry * gv[j][2]; h[3] = bf_hi(xw[r][j].y) + bf_hi(yw[r][j].y) * ry * gv[j][3];
                    s += (h[0] * h[0] + h[1] * h[1]) + (h[2] * h[2] + h[3] * h[3]); }
                sv[r] = wave_sum(s); }
#pragma unroll
            for (int r = 0; r < 2; ++r) if (r == 0 || two) { const int m = mm[r]; u32x2* o8 = (u32x2*)(Y + (size_t)m * D) + lane;
#pragma unroll
                for (int j = 0; j < 4; ++j) { u32x2 w; w.x = cvt_pk_bf16(v[r][j][0], v[r][j][1]); w.y = cvt_pk_bf16(v[r][j][2], v[r][j][3]); o8[64 * j] = w; }
                if (lane == 0) RS1[m] = rsqrtf(sv[r] * (1.f / D) + EPS); }
        }
    }
    SEAM(3);
    if (IN(4)) { pg8::Gemm g{Y, Win, M, NWIN, D, D, 0}; pg8::StaticOrder S; S.init(M, NWIN, G, (int)blockIdx.x);
        pg8::EpiWin E{LAT, XB, RS1, SSQ, SSKV}; pg8::gemm_phase(ldsl, g, S, E); }
    SEAM(4);
    if (IN(5)) {
        const float* cw = args.in[I_CONVW]; const float* cb = args.in[I_CONVB];
        const int cgp = tid & 127, stream = tid >> 7, ch0 = cgp * 8;
        float w[4][8], bsv[8];
#pragma unroll
        for (int j = 0; j < 4; ++j)
#pragma unroll
            for (int i = 0; i < 8; ++i) w[j][i] = cw[j * D + ch0 + i];
#pragma unroll
        for (int i = 0; i < 8; ++i) bsv[i] = cb[ch0 + i];
        constexpr int RUN = 16;
        for (int run = blockIdx.x * 4 + stream; run < M / RUN; run += G * 4) {
            const int r0 = run * RUN; const bool start = (r0 % SEQ) == 0;
            float h0[8], h1[8], h2[8];
            { u32x4 a = {0u, 0u, 0u, 0u}, b = a, c = a;
              if (!start) { a = *(const u32x4*)(XB + (size_t)(r0 - 3) * D + ch0); b = *(const u32x4*)(XB + (size_t)(r0 - 2) * D + ch0); c = *(const u32x4*)(XB + (size_t)(r0 - 1) * D + ch0); }
              h0[0] = bf_lo(a.x); h0[1] = bf_hi(a.x); h0[2] = bf_lo(a.y); h0[3] = bf_hi(a.y); h0[4] = bf_lo(a.z); h0[5] = bf_hi(a.z); h0[6] = bf_lo(a.w); h0[7] = bf_hi(a.w);
              h1[0] = bf_lo(b.x); h1[1] = bf_hi(b.x); h1[2] = bf_lo(b.y); h1[3] = bf_hi(b.y); h1[4] = bf_lo(b.z); h1[5] = bf_hi(b.z); h1[6] = bf_lo(b.w); h1[7] = bf_hi(b.w);
              h2[0] = bf_lo(c.x); h2[1] = bf_hi(c.x); h2[2] = bf_lo(c.y); h2[3] = bf_hi(c.y); h2[4] = bf_lo(c.z); h2[5] = bf_hi(c.z); h2[6] = bf_lo(c.w); h2[7] = bf_hi(c.w); }
#pragma unroll 4
            for (int rr = 0; rr < RUN; ++rr) {
                const u32x4 d = *(const u32x4*)(XB + (size_t)(r0 + rr) * D + ch0);
                const float h3[8] = {bf_lo(d.x), bf_hi(d.x), bf_lo(d.y), bf_hi(d.y), bf_lo(d.z), bf_hi(d.z), bf_lo(d.w), bf_hi(d.w)};
                float o[8];
#pragma unroll
                for (int i = 0; i < 8; ++i) { o[i] = bsv[i] + h0[i] * w[0][i] + h1[i] * w[1][i] + h2[i] * w[2][i] + h3[i] * w[3][i]; h0[i] = h1[i]; h1[i] = h2[i]; h2[i] = h3[i]; }
                u32x4 wv; wv.x = cvt_pk_bf16(o[0], o[1]); wv.y = cvt_pk_bf16(o[2], o[3]); wv.z = cvt_pk_bf16(o[4], o[5]); wv.w = cvt_pk_bf16(o[6], o[7]);
                *(u32x4*)(XN + (size_t)(r0 + rr) * D + ch0) = wv;
            }
        }
    }
    SEAM(5);
    if (IN(6)) { pg8::Gemm g{XN, Wgate, M, 2048, 128, D, 128}; pg8::StaticOrder S; S.init(M, 2048, G, (int)blockIdx.x);
        pg8::EpiLru E{XN, LA, args.in[I_BRG], args.in[I_BIG], NLA}; pg8::gemm_phase(ldsl, g, S, E); }
    SEAM(6);
    if (IN(7)) {
        for (int item = blockIdx.x; item < NB * NCHUNK; item += G) {
            const size_t r0 = (size_t)item * CHUNK; const int ch = tid * 2;
            float sl0 = 0.f, sl1 = 0.f, h0 = 0.f, h1 = 0.f;
#pragma unroll 8
            for (int i = 0; i < CHUNK; ++i) { const unsigned lw = *(const unsigned*)(LA + (r0 + i) * D + ch), gwv = *(const unsigned*)(XN + (r0 + i) * D + ch);
                const float l0 = bf_lo(lw), l1 = bf_hi(lw); sl0 += l0; sl1 += l1;
                h0 = __builtin_amdgcn_exp2f(l0 * 1.4426950408889634f) * h0 + bf_lo(gwv); h1 = __builtin_amdgcn_exp2f(l1 * 1.4426950408889634f) * h1 + bf_hi(gwv); }
            *(f32x4*)(PS + ((size_t)item * D + ch) * 2) = (f32x4){sl0, h0, sl1, h1};
        }
    }
    SEAM(7);
    if (IN(8)) {
        for (int item = blockIdx.x; item < NB * NCHUNK; item += G) {
            const int b = item / NCHUNK, c = item - b * NCHUNK; const size_t r0 = (size_t)item * CHUNK; const int ch = tid * 2;
            float h0 = 0.f, h1 = 0.f;
#pragma unroll 4
            for (int cc = 0; cc < c; ++cc) { const f32x4 p = *(const f32x4*)(PS + ((size_t)(b * NCHUNK + cc) * D + ch) * 2);
                h0 = __builtin_amdgcn_exp2f(p[0] * 1.4426950408889634f) * h0 + p[1]; h1 = __builtin_amdgcn_exp2f(p[2] * 1.4426950408889634f) * h1 + p[3]; }
#pragma unroll 8
            for (int i = 0; i < CHUNK; ++i) { const unsigned lw = *(const unsigned*)(LA + (r0 + i) * D + ch), gwv = *(const unsigned*)(XN + (r0 + i) * D + ch), yw = *(const unsigned*)(GY + (r0 + i) * D + ch);
                h0 = __builtin_amdgcn_exp2f(bf_lo(lw) * 1.4426950408889634f) * h0 + bf_lo(gwv); h1 = __builtin_amdgcn_exp2f(bf_hi(lw) * 1.4426950408889634f) * h1 + bf_hi(gwv);
                *(unsigned*)(XN + (r0 + i) * D + ch) = cvt_pk_bf16(h0 * bf_lo(yw), h1 * bf_hi(yw)); }
        }
    }
    SEAM(8);
    if (IN(9)) {
#ifndef P9SUB
#define P9SUB 7
#endif
        if (P9SUB & 1) { pg8::Gemm g{LAT, Wuq, M, 768, QLORA, LATP, 0}; pg8::StaticOrder S; S.init(M, 768, G, (int)blockIdx.x);
          pg8::EpiQ E{Qb, SSQ, CS}; pg8::gemm_phase(ldsl, g, S, E); }
        if (P9SUB & 2) { pg8::Gemm g{LAT + QLORA, Wukv, M, 1024, KVLORA, LATP, 0}; pg8::StaticOrder S; S.init(M, 1024, G, (int)blockIdx.x);
          pg8::EpiKV E{Kb, Vb, SSKV}; pg8::gemm_phase(ldsl, g, S, E); }
        if (P9SUB & 4) for (int i = blockIdx.x * 512 + tid; i < M * NHEAD; i += G * 512) { const int row = i >> 3, h = i & 7, b = row / SEQ, sp = row - b * SEQ;
            const u32x4* src = (const u32x4*)(LAT + (size_t)row * LATP + 640); const u32x4 a0 = src[0], a1 = src[1], b0 = src[2], b1 = src[3];
            const float x1[16] = {bf_lo(a0.x), bf_hi(a0.x), bf_lo(a0.y), bf_hi(a0.y), bf_lo(a0.z), bf_hi(a0.z), bf_lo(a0.w), bf_hi(a0.w), bf_lo(a1.x), bf_hi(a1.x), bf_lo(a1.y), bf_hi(a1.y), bf_lo(a1.z), bf_hi(a1.z), bf_lo(a1.w), bf_hi(a1.w)};
            const float x2[16] = {bf_lo(b0.x), bf_hi(b0.x), bf_lo(b0.y), bf_hi(b0.y), bf_lo(b0.z), bf_hi(b0.z), bf_lo(b0.w), bf_hi(b0.w), bf_lo(b1.x), bf_hi(b1.x), bf_lo(b1.y), bf_hi(b1.y), bf_lo(b1.z), bf_hi(b1.z), bf_lo(b1.w), bf_hi(b1.w)};
            const f32x4* cp = (const f32x4*)(CS + (size_t)row * 32); float o1[16], o2[16];
#pragma unroll
            for (int q = 0; q < 4; ++q) { const f32x4 cv = cp[q], sv = cp[4 + q];
#pragma unroll
                for (int e = 0; e < 4; ++e) { const int f = q * 4 + e; o1[f] = x1[f] * cv[e] - x2[f] * sv[e]; o2[f] = x2[f] * cv[e] + x1[f] * sv[e]; } }
            u32x4* dst = (u32x4*)(Kb + ((size_t)(b * NHEAD + h) * SEQ + sp) * DQK + 64);
            dst[0] = (u32x4){cvt_pk_bf16(o1[0], o1[1]), cvt_pk_bf16(o1[2], o1[3]), cvt_pk_bf16(o1[4], o1[5]), cvt_pk_bf16(o1[6], o1[7])};
            dst[1] = (u32x4){cvt_pk_bf16(o1[8], o1[9]), cvt_pk_bf16(o1[10], o1[11]), cvt_pk_bf16(o1[12], o1[13]), cvt_pk_bf16(o1[14], o1[15])};
            dst[2] = (u32x4){cvt_pk_bf16(o2[0], o2[1]), cvt_pk_bf16(o2[2], o2[3]), cvt_pk_bf16(o2[4], o2[5]), cvt_pk_bf16(o2[6], o2[7])};
            dst[3] = (u32x4){cvt_pk_bf16(o2[8], o2[9]), cvt_pk_bf16(o2[10], o2[11]), cvt_pk_bf16(o2[12], o2[13]), cvt_pk_bf16(o2[14], o2[15])}; }
    }
    SEAM(9);
    if (IN(10)) { att::attn_phase((char*)lds, (const att::bf16*)Qb, (const att::bf16*)Kb, (const att::bf16*)Vb, (att::bf16*)Ob); }
    SEAM(10);
    if (IN(11)) {
        { pg8::Gemm g{Ob, Wm, M, D, 512, 512, 0}; pg8::StaticOrder S; S.init(M, D, G, (int)blockIdx.x);
          pg8::EpiMerge<false> E{MG, SA}; pg8::gemm_phase(ldsl, g, S, E); }
        { pg8::Gemm g{XN, Wl, M, D, D, D, 0}; pg8::StaticOrder S; S.init(M, D, G, (int)blockIdx.x);
          pg8::EpiMerge<true> E{MG, SB}; pg8::gemm_phase(ldsl, g, S, E); }
    }
    SEAM(11);
    if (IN(12)) { pg8::Gemm g{MG, Wo, M, D, D, D, 0}; pg8::StaticOrder S; S.init(M, D, G, (int)blockIdx.x);
        pg8::EpiNormRes<false> E{nullptr, XN, SSZ, Y, args.in[I_MIXPOST], 1.0f, (float*)(ws + WS_XSLOT) + (size_t)M * 4, (unsigned*)(ws + WS_XCNT) + 128 * 64, (LAS float*)(ldsl + RING_BYTES)}; pg8::gemm_phase(ldsl, g, S, E); }
    SEAM(13);
    if (IN(14)) { pg8::Gemm g{XN, Wgu2, M, 2 * DFF, D, D, 0}; pg8::StaticOrder S; S.init(M, 2 * DFF, G, (int)blockIdx.x);
        pg8::EpiSwiGLU E{ACT, DFF, SSZ, true};   pg8::gemm_phase(ldsl, g, S, E); }
    SEAM(14);
    if (IN(15)) { pg8::Gemm g{ACT, Wd2, M, D, DFF, DFF, 0}; pg8::StaticOrder S; S.init(M, D, G, (int)blockIdx.x);
        pg8::EpiNormRes<true> E{out, nullptr, nullptr, XN, args.in[I_F2POST], 0.5f, (float*)(ws + WS_XSLOT) + (size_t)M * 8, (unsigned*)(ws + WS_XCNT) + 2 * 128 * 64, (LAS float*)(ldsl + RING_BYTES)}; pg8::gemm_phase(ldsl, g, S, E); }
#undef IN
#undef SEAM
}

extern "C" void kernel_launch(void* const* d_in, const int* in_sizes, int n_in, void* d_out, int out_size, void* d_ws, size_t ws_size, hipStream_t stream) {
    static int grid = 0;
    if (grid == 0) {
        if (n_in != 29 || in_sizes[0] != M * D || out_size != M * D || ws_size < WS_END) { fprintf(stderr, "kernel_launch: unexpected shapes (n_in %d, in0 %d, out %d, ws %zu)\n", n_in, n_in > 0 ? in_sizes[0] : -1, out_size, ws_size); grid = -1; return; }
        int dev = 0, cus = 0, per_cu = 0;
        (void)hipGetDevice(&dev); (void)hipDeviceGetAttribute(&cus, hipDeviceAttributeMultiprocessorCount, dev);
        if (hipFuncSetAttribute((const void*)mega_fwd, hipFuncAttributeMaxDynamicSharedMemorySize, LDS_BYTES) != hipSuccess) { fprintf(stderr, "kernel_launch: hipFuncSetAttribute failed\n"); grid = -1; return; }
        (void)hipOccupancyMaxActiveBlocksPerMultiprocessor(&per_cu, (const void*)mega_fwd, 512, LDS_BYTES);
        (void)hipGetLastError();
        if (per_cu < 1) fprintf(stderr, "kernel_launch: occupancy query reports %d blocks per CU\n", per_cu);
        grid = cus > 0 ? cus : 256;
    }
    if (grid < 0) return;
    Args a{};
    for (int i = 0; i < 29; ++i) a.in[i] = (const float*)d_in[i];
    a.out = (float*)d_out; a.ws = (unsigned char*)d_ws; a.ph_lo = 0; a.ph_hi = 17;
    void* kargs[] = {&a};
    hipError_t e = hipLaunchCooperativeKernel((const void*)mega_fwd, dim3(grid), dim3(512), kargs, LDS_BYTES, stream);
    if (e != hipSuccess) fprintf(stderr, "kernel_launch: cooperative launch failed: %s (grid %d)\n", hipGetErrorString(e), grid);
}
```
